# Optimizing an MI355X kernel written in HIP

```python
import jax, jax.numpy as jnp
from jax import lax
import numpy as np

D_MODEL = 1024
BATCH = 16
SEQ = 2048
DEPTH = 4

MEM_LEN = 256
EPS = 1e-6
N_NORMS = 8
D_FF = 2816
RW_HEADS = 8
RW_HEAD_DIM = 64
RW_WIDTH = RW_HEADS * RW_HEAD_DIM
RW_DECAY_RANK = 64
RW_AAA_RANK = 64
RW_GATE_RANK = 128
RW_LN_EPS = 64e-5
RW_SIZES = (RW_WIDTH, RW_WIDTH, RW_WIDTH, RW_DECAY_RANK, RW_AAA_RANK, RW_GATE_RANK)
RW_IN = 3 * RW_WIDTH + RW_DECAY_RANK + RW_AAA_RANK + RW_GATE_RANK
RT_HEADS = 4
RT_KEY_DIM = 128
RT_VAL_DIM = 128
RT_WIDTH = RT_HEADS * RT_VAL_DIM
RT_CHUNK = 128
RT_ROPE_BASE = 10000.0
RT_SIZES = (RT_HEADS * RT_KEY_DIM, RT_HEADS * RT_KEY_DIM, RT_WIDTH, RT_WIDTH)
RT_IN = 2 * RT_HEADS * RT_KEY_DIM + 2 * RT_WIDTH
EV_IN = RW_IN + RT_IN
EV_OUT = RW_WIDTH + RT_WIDTH
DSA_HEADS = 8
DSA_HEAD_DIM = 64
DSA_WIDTH = DSA_HEADS * DSA_HEAD_DIM
DSA_Q_RANK = 256
DSA_KV_RANK = 128
IDX_HEADS = 8
IDX_DIM = 64
TOPK_MAX = 256
Q_BLOCK = 128
DSA_SIZES = (DSA_Q_RANK, DSA_KV_RANK, IDX_DIM, IDX_HEADS)
DSA_IN = DSA_Q_RANK + DSA_KV_RANK + IDX_DIM + IDX_HEADS
SC_WIDTH = 512
SC_KERNEL = 3
SC_SIZES = (SC_WIDTH, SC_WIDTH, SC_WIDTH)
SC_IN = 3 * SC_WIDTH
OD_IN = DSA_IN + SC_IN
OD_OUT = DSA_WIDTH + SC_WIDTH
XA_HEADS = 4
XA_HEAD_DIM = 128
XA_WIDTH = XA_HEADS * XA_HEAD_DIM

kernel_name = 'hybrid_rwkv7_retnet_dsa_shortconv_block'

F32 = jnp.float32


def split_cols(t, sizes):
    out, start = [], 0
    for s in sizes:
        out.append(t[..., start:start + s])
        start += s
    return out


def rms_norm(x, g, eps=EPS):
    xf = x.astype(F32)
    y = xf * lax.rsqrt(jnp.mean(xf * xf, axis=-1, keepdims=True) + eps)
    return (y * g.astype(F32)).astype(x.dtype)


def group_norm_heads(x, g, b, eps):
    xf = x.astype(F32)
    mu = jnp.mean(xf, axis=-1, keepdims=True)
    var = jnp.mean(jnp.square(xf - mu), axis=-1, keepdims=True)
    y = ((xf - mu) * lax.rsqrt(var + eps)).reshape(*x.shape[:-2], -1)
    return y * g.astype(F32) + b.astype(F32)


def token_shift(p):
    return jnp.pad(p, ((0, 0), (1, 0), (0, 0)))[:, :-1]


def swiglu(x, w_gate, w_up, w_down):
    return (jax.nn.silu(x @ w_gate) * (x @ w_up)) @ w_down


def rotary(x, positions):
    half = x.shape[-1] // 2
    inv_freq = RT_ROPE_BASE ** (-jnp.arange(half, dtype=F32) / half)
    ang = positions.astype(F32)[:, None] * inv_freq[None, :]
    cos = jnp.cos(ang)[None, :, None, :]
    sin = jnp.sin(ang)[None, :, None, :]
    x1, x2 = x[..., :half].astype(F32), x[..., half:].astype(F32)
    return jnp.concatenate([x1 * cos - x2 * sin, x1 * sin + x2 * cos], axis=-1).astype(x.dtype)


def rwkv7_mix(p, mu, w0, w2, a0, a2, g2, k_k, k_a, r_k, ln_g, ln_b):
    b_, s_, _ = p.shape
    p = p + (token_shift(p) - p) * mu
    r, k, v, xw, xa, xg = split_cols(p, RW_SIZES)
    w = -jax.nn.softplus(-(w0 + jnp.tanh(xw) @ w2)) - 0.5
    decay = jnp.exp(-jnp.exp(w.astype(F32)))
    a = jax.nn.sigmoid(a0 + xa @ a2)
    g = jax.nn.sigmoid(xg) @ g2
    heads = lambda t: t.reshape(b_, s_, RW_HEADS, RW_HEAD_DIM)
    kk = heads(k * k_k).astype(F32)
    kk = kk / jnp.maximum(jnp.sqrt(jnp.sum(kk * kk, axis=-1, keepdims=True)), 1e-12)
    k = k * (1 + (a - 1) * k_a)
    rh, kh, vh, ah = heads(r), heads(k), heads(v), heads(a).astype(F32)
    xs = tuple(jnp.moveaxis(t.astype(F32), 1, 0) for t in (rh, heads(decay), kh, vh, -kk, kk * ah))

    def step(state, inp):
        r_t, w_t, k_t, v_t, a_t, b_t = inp
        sa = jnp.einsum('bhvk,bhk->bhv', state, a_t)
        state = (state * w_t[:, :, None, :] + sa[..., None] * b_t[:, :, None, :]
                 + v_t[..., None] * k_t[:, :, None, :])
        return state, jnp.einsum('bhvk,bhk->bhv', state, r_t)

    state0 = jnp.zeros((b_, RW_HEADS, RW_HEAD_DIM, RW_HEAD_DIM), F32)
    _, y = lax.scan(step, state0, xs)
    y = group_norm_heads(jnp.moveaxis(y, 0, 1), ln_g, ln_b, RW_LN_EPS)
    bonus = jnp.sum(rh * kh * r_k, axis=-1, keepdims=True) * vh
    y = (y + bonus.reshape(b_, s_, RW_WIDTH).astype(F32)) * g.astype(F32)
    return y.astype(p.dtype)


def retention_mix(p, positions, gn_g, gn_b):
    b_, s_, _ = p.shape
    q, k, v, g = split_cols(p, RT_SIZES)
    q = rotary(q.reshape(b_, s_, RT_HEADS, RT_KEY_DIM), positions)
    k = rotary(k.reshape(b_, s_, RT_HEADS, RT_KEY_DIM), positions) * (RT_KEY_DIM ** -0.5)
    v = v.reshape(b_, s_, RT_HEADS, RT_VAL_DIM)
    n_chunks = s_ // RT_CHUNK
    chunk = lambda t: t.reshape(b_, n_chunks, RT_CHUNK, *t.shape[2:]).astype(F32)
    qc, kc, vc = chunk(q), chunk(k), chunk(v)
    log_gamma = jnp.log1p(-jnp.exp2(-5.0 - jnp.arange(RT_HEADS, dtype=F32)))
    idx = jnp.arange(RT_CHUNK, dtype=F32)
    rel = idx[:, None] - idx[None, :]
    decay_mask = jnp.where(rel[None] >= 0,
                           jnp.exp(jnp.maximum(rel, 0.0)[None] * log_gamma[:, None, None]), 0.0)
    scores = jnp.einsum('bnihd,bnjhd->bnhij', qc, kc) * decay_mask
    o_inner = jnp.einsum('bnhij,bnjhe->bnihe', scores, vc)
    zeta = jnp.exp((RT_CHUNK - 1 - idx)[None, :] * log_gamma[:, None])
    kv = jnp.einsum('bnjhd,hj,bnjhe->bnhde', kc, zeta, vc)
    chunk_gamma = jnp.exp(RT_CHUNK * log_gamma)[None, :, None, None]

    def step(state, kv_n):
        return state * chunk_gamma + kv_n, state

    state0 = jnp.zeros((b_, RT_HEADS, RT_KEY_DIM, RT_VAL_DIM), F32)
    _, r_prev = lax.scan(step, state0, jnp.moveaxis(kv, 1, 0))
    r_prev = jnp.moveaxis(r_prev, 0, 1)
    xi = jnp.exp((idx + 1)[:, None] * log_gamma[None, :])
    o_cross = jnp.einsum('bnihd,bnhde->bnihe', qc, r_prev) * xi[:, :, None]
    o = (o_inner + o_cross).reshape(b_, s_, RT_HEADS, RT_VAL_DIM)
    o = group_norm_heads(o, gn_g, gn_b, EPS)
    return (jax.nn.silu(g.astype(F32)) * o).astype(p.dtype)


def dsa_mix(p, q_norm_g, kv_norm_g, w_uq, w_uk, w_uv, w_qi):
    b_, s_, _ = p.shape
    c_q, c_kv, k_idx, w_idx = split_cols(p, DSA_SIZES)
    c_q = rms_norm(c_q, q_norm_g)
    c_kv = rms_norm(c_kv, kv_norm_g)
    q = jnp.einsum('btr,rhd->bthd', c_q, w_uq)
    q_lat = jnp.einsum('bthd,hdc->bthc', q, w_uk)
    q_idx = jnp.einsum('btr,rhd->bthd', c_q, w_qi)
    w_idx = w_idx * ((IDX_HEADS * IDX_DIM) ** -0.5)
    top_k = min(TOPK_MAX, s_ // 4)
    n_blocks = s_ // Q_BLOCK
    key_pos = jnp.arange(s_)

    def to_blocks(t):
        return jnp.moveaxis(t.reshape(b_, n_blocks, Q_BLOCK, *t.shape[2:]), 1, 0)

    def block(args):
        blk, ql, qi, wi = args
        q_pos = blk * Q_BLOCK + jnp.arange(Q_BLOCK)
        logits = jnp.einsum('bthd,bsd->bths', qi, k_idx)
        score = jnp.einsum('bth,bths->bts', wi, jax.nn.relu(logits)).astype(F32)
        causal = key_pos[None, :] <= q_pos[:, None]
        score = jnp.where(causal[None], score, -jnp.inf)
        top_val, top_idx = lax.top_k(score, top_k)
        valid = jnp.isfinite(top_val)
        sel = jax.vmap(lambda c, i: c[i])(c_kv, top_idx)
        s = jnp.einsum('bthc,btkc->bthk', ql, sel).astype(F32) * (DSA_HEAD_DIM ** -0.5)
        s = jnp.where(valid[:, :, None, :], s, -jnp.inf)
        prob = jax.nn.softmax(s, axis=-1).astype(sel.dtype)
        return jnp.einsum('bthk,btkc->bthc', prob, sel)

    o_lat = lax.map(block, (jnp.arange(n_blocks), to_blocks(q_lat), to_blocks(q_idx), to_blocks(w_idx)))
    o_lat = jnp.moveaxis(o_lat, 0, 1).reshape(b_, s_, DSA_HEADS, DSA_KV_RANK)
    o = jnp.einsum('bthc,hcd->bthd', o_lat, w_uv)
    return o.reshape(b_, s_, DSA_WIDTH).astype(p.dtype)


def short_conv_mix(p, conv_w, conv_b):
    h, gate_b, gate_c = split_cols(p, SC_SIZES)
    u = gate_c * h
    y = lax.conv_general_dilated(u, conv_w[:, None, :].astype(u.dtype), window_strides=(1,),
                                 padding=[(SC_KERNEL - 1, 0)],
                                 dimension_numbers=('NWC', 'WIO', 'NWC'),
                                 feature_group_count=SC_WIDTH) + conv_b
    return (gate_b * y).astype(p.dtype)


def memory_xattn(h, mem_n, wq, wk, wv, wo):
    b_, s_, _ = h.shape
    m_ = mem_n.shape[1]
    q = (h @ wq).reshape(b_, s_, XA_HEADS, XA_HEAD_DIM)
    k = (mem_n @ wk).reshape(b_, m_, XA_HEADS, XA_HEAD_DIM)
    v = (mem_n @ wv).reshape(b_, m_, XA_HEADS, XA_HEAD_DIM)
    s = jnp.einsum('bthd,bmhd->bhtm', q, k).astype(F32) * (XA_HEAD_DIM ** -0.5)
    prob = jax.nn.softmax(s, axis=-1).astype(v.dtype)
    o = jnp.einsum('bhtm,bmhd->bthd', prob, v).reshape(b_, s_, XA_WIDTH)
    return o @ wo


def setup_inputs(seed: int = 0) -> dict:
    key = jax.random.key(seed)
    ks = iter(jax.random.split(key, 48))
    n_even = (DEPTH + 1) // 2
    n_odd = DEPTH // 2
    nrm = lambda shape, scale: jax.random.normal(next(ks), shape, F32) * scale
    gain = lambda shape: 1.0 + nrm(shape, 0.02)
    uni = lambda shape, lo, hi: jax.random.uniform(next(ks), shape, F32, lo, hi)
    return {
        'x': nrm((BATCH, SEQ, D_MODEL), 1.0),
        'mem': nrm((BATCH, MEM_LEN, D_MODEL), 1.0),
        'norm_g': gain((DEPTH, N_NORMS, D_MODEL)),
        'mem_norm_g': gain((D_MODEL,)),
        'ffn_w_gate': nrm((DEPTH, 2, D_MODEL, D_FF), D_MODEL ** -0.5),
        'ffn_w_up': nrm((DEPTH, 2, D_MODEL, D_FF), D_MODEL ** -0.5),
        'ffn_w_down': nrm((DEPTH, 2, D_FF, D_MODEL), D_FF ** -0.5),
        'xa_wq': nrm((DEPTH, D_MODEL, XA_WIDTH), D_MODEL ** -0.5),
        'xa_wk': nrm((DEPTH, D_MODEL, XA_WIDTH), D_MODEL ** -0.5),
        'xa_wv': nrm((DEPTH, D_MODEL, XA_WIDTH), D_MODEL ** -0.5),
        'xa_wo': nrm((DEPTH, XA_WIDTH, D_MODEL), XA_WIDTH ** -0.5),
        'ev_w_in': nrm((n_even, D_MODEL, EV_IN), D_MODEL ** -0.5),
        'ev_w_out': nrm((n_even, EV_OUT, D_MODEL), EV_OUT ** -0.5),
        'rw_mu': uni((n_even, RW_IN), 0.0, 1.0),
        'rw_w0': uni((n_even, RW_WIDTH), -6.0, 1.0),
        'rw_w2': nrm((n_even, RW_DECAY_RANK, RW_WIDTH), 0.5 * RW_DECAY_RANK ** -0.5),
        'rw_a0': nrm((n_even, RW_WIDTH), 0.1),
        'rw_a2': nrm((n_even, RW_AAA_RANK, RW_WIDTH), 0.5 * RW_AAA_RANK ** -0.5),
        'rw_g2': nrm((n_even, RW_GATE_RANK, RW_WIDTH), RW_GATE_RANK ** -0.5),
        'rw_k_k': 0.85 + nrm((n_even, RW_WIDTH), 0.05),
        'rw_k_a': 1.0 + nrm((n_even, RW_WIDTH), 0.05),
        'rw_r_k': nrm((n_even, RW_HEADS, RW_HEAD_DIM), 0.1),
        'rw_ln_g': gain((n_even, RW_WIDTH)),
        'rw_ln_b': nrm((n_even, RW_WIDTH), 0.02),
        'rt_gn_g': gain((n_even, RT_WIDTH)),
        'rt_gn_b': nrm((n_even, RT_WIDTH), 0.02),
        'od_w_in': nrm((n_odd, D_MODEL, OD_IN), D_MODEL ** -0.5),
        'od_w_out': nrm((n_odd, OD_OUT, D_MODEL), OD_OUT ** -0.5),
        'dsa_q_norm_g': gain((n_odd, DSA_Q_RANK)),
        'dsa_kv_norm_g': gain((n_odd, DSA_KV_RANK)),
        'dsa_w_uq': nrm((n_odd, DSA_Q_RANK, DSA_HEADS, DSA_HEAD_DIM), DSA_Q_RANK ** -0.5),
        'dsa_w_uk': nrm((n_odd, DSA_HEADS, DSA_HEAD_DIM, DSA_KV_RANK), DSA_HEAD_DIM ** -0.5),
        'dsa_w_uv': nrm((n_odd, DSA_HEADS, DSA_KV_RANK, DSA_HEAD_DIM), DSA_KV_RANK ** -0.5),
        'dsa_w_qi': nrm((n_odd, DSA_Q_RANK, IDX_HEADS, IDX_DIM), DSA_Q_RANK ** -0.5),
        'sc_conv_w': nrm((n_odd, SC_KERNEL, SC_WIDTH), SC_KERNEL ** -0.5),
        'sc_conv_b': nrm((n_odd, SC_WIDTH), 0.02),
    }


def reference(x, mem, norm_g, mem_norm_g, ffn_w_gate, ffn_w_up, ffn_w_down,
              xa_wq, xa_wk, xa_wv, xa_wo, ev_w_in, ev_w_out,
              rw_mu, rw_w0, rw_w2, rw_a0, rw_a2, rw_g2, rw_k_k, rw_k_a, rw_r_k, rw_ln_g, rw_ln_b,
              rt_gn_g, rt_gn_b, od_w_in, od_w_out,
              dsa_q_norm_g, dsa_kv_norm_g, dsa_w_uq, dsa_w_uk, dsa_w_uv, dsa_w_qi,
              sc_conv_w, sc_conv_b):
    mem_n = rms_norm(mem, mem_norm_g)
    positions = jnp.arange(x.shape[1])
    for l in range(DEPTH):
        ng = norm_g[l]
        h = swiglu(rms_norm(x, ng[0]), ffn_w_gate[l, 0], ffn_w_up[l, 0], ffn_w_down[l, 0])
        x = x + 0.5 * rms_norm(h, ng[1])
        h = rms_norm(x, ng[2])
        i = l // 2
        if l % 2 == 0:
            p = h @ ev_w_in[i]
            y_a = rwkv7_mix(p[..., :RW_IN], rw_mu[i], rw_w0[i], rw_w2[i], rw_a0[i], rw_a2[i],
                            rw_g2[i], rw_k_k[i], rw_k_a[i], rw_r_k[i], rw_ln_g[i], rw_ln_b[i])
            y_b = retention_mix(p[..., RW_IN:], positions, rt_gn_g[i], rt_gn_b[i])
            h = jnp.concatenate([y_a, y_b], axis=-1) @ ev_w_out[i]
        else:
            p = h @ od_w_in[i]
            y_c = dsa_mix(p[..., :DSA_IN], dsa_q_norm_g[i], dsa_kv_norm_g[i], dsa_w_uq[i],
                          dsa_w_uk[i], dsa_w_uv[i], dsa_w_qi[i])
            y_d = short_conv_mix(p[..., DSA_IN:], sc_conv_w[i], sc_conv_b[i])
            h = jnp.concatenate([y_c, y_d], axis=-1) @ od_w_out[i]
        x = x + rms_norm(h, ng[3])
        h = memory_xattn(rms_norm(x, ng[4]), mem_n, xa_wq[l], xa_wk[l], xa_wv[l], xa_wo[l])
        x = x + rms_norm(h, ng[5])
        h = swiglu(rms_norm(x, ng[6]), ffn_w_gate[l, 1], ffn_w_up[l, 1], ffn_w_down[l, 1])
        x = x + 0.5 * rms_norm(h, ng[7])
    return x
```

```cpp
#ifndef EMU
#include <hip/hip_runtime.h>
#endif
#include <cstdio>
#include <cstdint>
#include <cstring>

#ifndef CFG_B
#define CFG_B 16
#endif
#ifndef CFG_S
#define CFG_S 2048
#endif
#ifndef CFG_DEPTH
#define CFG_DEPTH 4
#endif
#ifndef PROBE_SLOT
#define PROBE_SLOT -1
#define PROBE_N 1
#endif
#define RPT(sl) _Pragma("unroll 1") for (int rep_ = 0; rep_ < ((sl) == PROBE_SLOT ? PROBE_N : 1); ++rep_)
#ifndef MK_N_LAUNCHES
#define MK_N_LAUNCHES 1
#endif

typedef unsigned short bf16_t;
typedef short bf16x8 __attribute__((ext_vector_type(8)));
typedef float f32x4 __attribute__((ext_vector_type(4)));
typedef float f32x2 __attribute__((ext_vector_type(2)));
typedef unsigned u32x4 __attribute__((ext_vector_type(4)));
typedef unsigned u32x2 __attribute__((ext_vector_type(2)));

#ifdef EMU
#define LAS
#define GAS
#define WAIT_VM(n) do { } while (0)
#define WAIT_LGKM(n) emu_wave_sync()
#define WAIT_ALL() do { } while (0)
#define S_BARRIER() emu_barrier()
#define SYNC() emu_barrier()
#define LSYNC() emu_barrier()
#define SCHED_FENCE() do { } while (0)
#define SETPRIO(n) do { } while (0)
#define COMPILER_FENCE() do { } while (0)
static inline int rfl(int v) { return v; }
static inline f32x4 mfma16(bf16x8 a, bf16x8 b, f32x4 c) {
    struct AB { bf16x8 a, b; } mine{a, b};
    auto s = emu_xchg(&mine, sizeof(mine));
    const int lane = emu_cur()->tid & 63, col = lane & 15; f32x4 r = c;
    for (int i = 0; i < 4; ++i) { const int row = (lane >> 4) * 4 + i; float acc = 0.f;
        for (int g = 0; g < 4; ++g) { const AB* pa = (const AB*)s[row + 16 * g]; const AB* pb = (const AB*)s[col + 16 * g];
            for (int j = 0; j < 8; ++j) acc += emu_bf2f((unsigned short)pa->a[j]) * emu_bf2f((unsigned short)pb->b[j]); }
        r[i] += acc; }
    emu_wave_sync(); return r;
}
static inline void glds16(const void* g, unsigned char* lbase) { memcpy(lbase + (emu_cur()->tid & 63) * 16, g, 16); }
static inline unsigned long long ballot64(bool p) { return emu_ballot(p); }
static inline int popc64(unsigned long long v) { return __builtin_popcountll(v); }
static inline void setlane64(unsigned long long& w, unsigned long long bits, int i, int lane) { if (lane == i) w = bits; }
static inline unsigned atom_ld(unsigned* p) { return __atomic_load_n(p, __ATOMIC_SEQ_CST); }
static inline unsigned atom_add(unsigned* p, unsigned v) { return __atomic_fetch_add(p, v, __ATOMIC_SEQ_CST); }
static inline unsigned xcc_id() { return (unsigned)blockIdx.x & 7u; }
static inline void s_sleep1() { emu_spin_yield(); }
static inline void fence_release() { __atomic_thread_fence(__ATOMIC_SEQ_CST); }
static inline void fence_acquire() { __atomic_thread_fence(__ATOMIC_SEQ_CST); }
#define DYN_LDS(name) unsigned char* name = emu_lds()
#define LAUNDER_V(x) do { } while (0)
#define LAUNDER_S(x) do { } while (0)
#else
#define LAUNDER_V(x) asm volatile("" : "+v"(x))
#define LAUNDER_S(x) asm volatile("" : "+s"(x))
#define LAS __attribute__((address_space(3)))
#define GAS __attribute__((address_space(1)))
#define WAIT_VM(n) asm volatile("s_waitcnt vmcnt(" #n ")" ::: "memory")
#define WAIT_LGKM(n) asm volatile("s_waitcnt lgkmcnt(" #n ")" ::: "memory")
#define WAIT_ALL() asm volatile("s_waitcnt vmcnt(0) lgkmcnt(0)" ::: "memory")
#define S_BARRIER() __builtin_amdgcn_s_barrier()
#define SYNC() __syncthreads()
#define LSYNC() do { asm volatile("s_waitcnt lgkmcnt(0)" ::: "memory"); __builtin_amdgcn_s_barrier(); asm volatile("" ::: "memory"); } while (0)
#define SCHED_FENCE() __builtin_amdgcn_sched_barrier(0)
#define SETPRIO(n) __builtin_amdgcn_s_setprio(n)
#define COMPILER_FENCE() asm volatile("" ::: "memory")
__device__ __forceinline__ int rfl(int v) { return __builtin_amdgcn_readfirstlane(v); }
__device__ __forceinline__ f32x4 mfma16(bf16x8 a, bf16x8 b, f32x4 c) { return __builtin_amdgcn_mfma_f32_16x16x32_bf16(a, b, c, 0, 0, 0); }
__device__ __forceinline__ void glds16(const void* g, LAS unsigned char* lbase) { __builtin_amdgcn_global_load_lds((const unsigned*)g, (LAS unsigned*)lbase, 16, 0, 0); }
__device__ __forceinline__ unsigned long long ballot64(bool p) { return __ballot(p); }
__device__ __forceinline__ int popc64(unsigned long long v) { return __builtin_popcountll(v); }
__device__ __forceinline__ void setlane64(unsigned long long& w, unsigned long long bits, int i, int) {
    unsigned lo = (unsigned)w, hi = (unsigned)(w >> 32);
    asm("s_nop 1\n\tv_writelane_b32 %0, %2, %4\n\tv_writelane_b32 %1, %3, %4" : "+v"(lo), "+v"(hi) : "s"((unsigned)bits), "s"((unsigned)(bits >> 32)), "i"(i));
    w = ((unsigned long long)hi << 32) | lo; }
__device__ __forceinline__ unsigned atom_ld(unsigned* p) { return __hip_atomic_load(p, __ATOMIC_RELAXED, __HIP_MEMORY_SCOPE_AGENT); }
__device__ __forceinline__ unsigned atom_add(unsigned* p, unsigned v) { return __hip_atomic_fetch_add(p, v, __ATOMIC_RELAXED, __HIP_MEMORY_SCOPE_AGENT); }
__device__ __forceinline__ unsigned xcc_id() { return (unsigned)__builtin_amdgcn_s_getreg((3 << 11) | 20) & 0xFu; }
__device__ __forceinline__ void s_sleep1() { __builtin_amdgcn_s_sleep(1); }
__device__ __forceinline__ void fence_release() { __builtin_amdgcn_fence(__ATOMIC_RELEASE, "agent"); }
__device__ __forceinline__ void fence_acquire() { __builtin_amdgcn_fence(__ATOMIC_ACQUIRE, "agent"); }
#define DYN_LDS(name) extern __shared__ __attribute__((aligned(16))) unsigned char name##_raw[]; LAS unsigned char* name = (LAS unsigned char*)name##_raw
#endif

#ifdef EMU
__host__ __device__ __forceinline__ unsigned f2bf(float f) { unsigned u; memcpy(&u, &f, 4); return (u + 0x7fffu + ((u >> 16) & 1u)) >> 16; }
__host__ __device__ __forceinline__ unsigned pk2(float lo, float hi) { return f2bf(lo) | (f2bf(hi) << 16); }
static inline float frsq(float x) { return 1.f / sqrtf(x); }
#else
typedef __bf16 bf16x2_t __attribute__((ext_vector_type(2)));
__device__ __forceinline__ unsigned pk2(float lo, float hi) { const f32x2 v = {lo, hi}; return __builtin_bit_cast(unsigned, __builtin_convertvector(v, bf16x2_t)); }
__device__ __forceinline__ unsigned f2bf(float f) { return pk2(f, 0.f) & 0xffffu; }
__device__ __forceinline__ float frsq(float x) { return __builtin_amdgcn_rsqf(x); }
#endif
__host__ __device__ __forceinline__ float bf2f(unsigned b) { unsigned u = b << 16; float f; memcpy(&f, &u, 4); return f; }
__device__ __forceinline__ float bflo(unsigned w) { return bf2f(w & 0xffffu); }
__device__ __forceinline__ float bfhi(unsigned w) { return bf2f(w >> 16); }
#ifdef EMU
template <class T> static inline T shfl_xor_(T v, int m) { return __shfl_xor(v, m); }
template <class T> static inline T shfl_(T v, int l) { return __shfl(v, l); }
#else
__device__ __forceinline__ int lane_now() { int l = __builtin_amdgcn_mbcnt_hi(-1, __builtin_amdgcn_mbcnt_lo(-1, 0)); asm volatile("" : "+v"(l)); return l; }
__device__ __forceinline__ float shfl_xor_(float v, int m) { return __builtin_bit_cast(float, __builtin_amdgcn_ds_bpermute((lane_now() ^ m) << 2, __builtin_bit_cast(int, v))); }
__device__ __forceinline__ float shfl_(float v, int l) { return __builtin_bit_cast(float, __builtin_amdgcn_ds_bpermute(l << 2, __builtin_bit_cast(int, v))); }
#endif
#ifdef EMU
static inline void xr16_pair(float v, float& a, float& b) { const float o = shfl_xor_(v, 16); const int l = emu_cur()->tid & 63; if (l & 16) { a = o; b = v; } else { a = v; b = o; } }
static inline void xr32_pair(float v, float& a, float& b) { const float o = shfl_xor_(v, 32); const int l = emu_cur()->tid & 63; if (l & 32) { a = o; b = v; } else { a = v; b = o; } }
#else
__device__ __forceinline__ void xr16_pair(float v, float& a, float& b) { a = v; b = v; asm("s_nop 1\n\tv_permlane16_swap_b32 %0, %1" : "+v"(a), "+v"(b)); }
__device__ __forceinline__ void xr32_pair(float v, float& a, float& b) { a = v; b = v; asm("s_nop 1\n\tv_permlane32_swap_b32 %0, %1" : "+v"(a), "+v"(b)); }
#endif
#ifdef EMU
static inline void xr16_swap2(float& v0, float& v1) { const float p0 = shfl_xor_(v0, 16), p1 = shfl_xor_(v1, 16); const int l = emu_cur()->tid & 63; if (l & 16) v0 = p1; else v1 = p0; }
#else
__device__ __forceinline__ void xr16_swap2(float& v0, float& v1) { asm("s_nop 1\n\tv_permlane16_swap_b32 %0, %1" : "+v"(v0), "+v"(v1)); }
#endif
__device__ __forceinline__ float xr16_sum(float v) { float a, b; xr16_pair(v, a, b); return a + b; }
__device__ __forceinline__ float xr32_sum(float v) { float a, b; xr32_pair(v, a, b); return a + b; }
__device__ __forceinline__ float xr16_max(float v) { float a, b; xr16_pair(v, a, b); return fmaxf(a, b); }
__device__ __forceinline__ float xr32_max(float v) { float a, b; xr32_pair(v, a, b); return fmaxf(a, b); }
__device__ __forceinline__ float sum16d(float v);
__device__ __forceinline__ float wave_sum(float v) { return xr32_sum(xr16_sum(sum16d(v))); }
__device__ __forceinline__ float sum16(float v) { v += shfl_xor_(v, 1); v += shfl_xor_(v, 2); v += shfl_xor_(v, 4); v += shfl_xor_(v, 8); return v; }
__device__ __forceinline__ float max16(float v) { v = fmaxf(v, shfl_xor_(v, 1)); v = fmaxf(v, shfl_xor_(v, 2)); v = fmaxf(v, shfl_xor_(v, 4)); v = fmaxf(v, shfl_xor_(v, 8)); return v; }
__device__ __forceinline__ float sum8(float v) { v += shfl_xor_(v, 1); v += shfl_xor_(v, 2); v += shfl_xor_(v, 4); return v; }
#ifdef EMU
static inline float fexp2(float x) { return exp2f(x); }
static inline int bfe_i1(unsigned v, int pos) { return -(int)((v >> pos) & 1u); }
#else
__device__ __forceinline__ float fexp2(float x) { return __builtin_amdgcn_exp2f(x); }
__device__ __forceinline__ int bfe_i1(unsigned v, int pos) { int r; asm("v_bfe_i32 %0, %1, %2, 1" : "=v"(r) : "v"(v), "s"(pos)); return r; }
#endif
#ifdef EMU
static inline float frcp(float x) { return 1.f / x; }
#else
__device__ __forceinline__ float frcp(float x) { return __builtin_amdgcn_rcpf(x); }
#endif
__device__ __forceinline__ float sigmoidf_(float x) { return frcp(1.f + __expf(-x)); }
#ifdef EMU
template <int CTRL> static inline float dppf(float x) { const int l = emu_cur()->tid & 63;
    const int src = CTRL == 0xB1 ? (l ^ 1) : CTRL == 0x4E ? (l ^ 2) : CTRL == 0x141 ? ((l & ~7) | (7 - (l & 7))) : ((l & ~15) | (15 - (l & 15))); return emu_shfl(x, src); }
#else
template <int CTRL> __device__ __forceinline__ float dppf(float x) { return __builtin_bit_cast(float, __builtin_amdgcn_mov_dpp(__builtin_bit_cast(int, x), CTRL, 0xf, 0xf, true)); }
#endif
#ifdef EMU
template <int CTRL> static inline int dppi(int x) { return __builtin_bit_cast(int, dppf<CTRL>(__builtin_bit_cast(float, x))); }
static inline int readlane_i(int x, int l) { return emu_shfl(x, l); }
#else
template <int CTRL> __device__ __forceinline__ int dppi(int x) { return __builtin_amdgcn_mov_dpp(x, CTRL, 0xf, 0xf, true); }
__device__ __forceinline__ int readlane_i(int x, int l) { return __builtin_amdgcn_readlane(x, l); }
#endif
__device__ __forceinline__ float readlane_f(float x, int l) { return __builtin_bit_cast(float, readlane_i(__builtin_bit_cast(int, x), l)); }
__device__ __forceinline__ int wave_isum(int v) { v += dppi<0xB1>(v); v += dppi<0x4E>(v); v += dppi<0x141>(v); v += dppi<0x140>(v);
    return (readlane_i(v, 0) + readlane_i(v, 16)) + (readlane_i(v, 32) + readlane_i(v, 48)); }
__device__ __forceinline__ float sum8d(float v) { v += dppf<0xB1>(v); v += dppf<0x4E>(v); v += dppf<0x141>(v); return v; }
__device__ __forceinline__ float sum16d(float v) { v = sum8d(v); v += dppf<0x140>(v); return v; }
__device__ __forceinline__ float max16d(float v) { v = fmaxf(v, dppf<0xB1>(v)); v = fmaxf(v, dppf<0x4E>(v)); v = fmaxf(v, dppf<0x141>(v)); v = fmaxf(v, dppf<0x140>(v)); return v; }

constexpr int NB = CFG_B, SEQ = CFG_S, DEPTH = CFG_DEPTH, D = 1024, M = NB * SEQ, MEML = 256, MM = NB * MEML, DFF = 2816, NGU = 2 * DFF;
constexpr int TOPK = (256 < SEQ / 4) ? 256 : SEQ / 4;
constexpr int EV_IN = 3840, RW_IN = 1792, OD_INP = 2048  , OD_Y = 1536, DQN = 1536;
constexpr float EPS = 1e-6f, RW_LN_EPS = 64e-5f;
constexpr int NTHREADS = 512, NWAVES = 8;
constexpr int LDS_BYTES = 147456;
constexpr int LDS_MISC = 131072 + 12288, LDS_TAB = LDS_MISC + 256;
constexpr int SLOTS = 18;
constexpr int NPH = DEPTH * SLOTS;

constexpr size_t MiB = 1u << 20;
constexpr size_t al256(size_t x) { return (x + 255) & ~(size_t)255; }
constexpr size_t WS_CTL = 0, CTL_BYTES = 96 * 1024;
constexpr size_t WS_ROPE = WS_CTL + CTL_BYTES;
constexpr size_t WS_WGU = al256(WS_ROPE + (size_t)SEQ * 64 * 2 * 4);
constexpr size_t WS_WDN = WS_WGU + (size_t)2 * NGU * D * 2;
constexpr size_t WS_WQ = WS_WDN + (size_t)2 * D * DFF * 2;
constexpr size_t WS_WK = WS_WQ + (size_t)512 * D * 2;
constexpr size_t WS_WV = WS_WK + (size_t)512 * D * 2;
constexpr size_t WS_WO = WS_WV + (size_t)512 * D * 2;
constexpr size_t WS_WIN = WS_WO + (size_t)D * 512 * 2;
constexpr size_t WS_WOUT = WS_WIN + (size_t)EV_IN * D * 2;
constexpr size_t WS_WDQ = WS_WOUT + (size_t)D * OD_Y * 2;
constexpr size_t WS_W2T = WS_WDQ + (size_t)DQN * 256 * 2;
constexpr size_t WS_A2T = WS_W2T + (size_t)512 * 64 * 2;
constexpr size_t WS_G2T = WS_A2T + (size_t)512 * 64 * 2;
constexpr size_t WS_MEMN = al256(WS_G2T + (size_t)512 * 128 * 2);
constexpr size_t WS_KB = WS_MEMN + (size_t)MM * D * 2;
constexpr size_t WS_VT = WS_KB + (size_t)MM * 512 * 2;
constexpr size_t WS_XN = al256(WS_VT + (size_t)512 * MM * 2);
constexpr size_t WS_Y = WS_XN + (size_t)M * D * 2;
constexpr size_t WS_CQN = WS_Y + (size_t)M * OD_Y * 2;
constexpr size_t WS_CKV = WS_CQN + (size_t)M * 256 * 2;
constexpr size_t WS_CKVT = WS_CKV + (size_t)M * 128 * 2;
constexpr size_t WS_WI = WS_CKVT + (size_t)M * 128 * 2;
constexpr size_t WS_RSTD = al256(WS_WI + (size_t)M * 8 * 4);
constexpr size_t WS_KI = al256(WS_RSTD + (size_t)M * 4);
constexpr size_t WS_MASK = al256(WS_KI + (size_t)M * 64 * 2);
constexpr size_t WS_BIG = al256(WS_MASK + (size_t)M * (SEQ / 64) * 8);
constexpr size_t BIG_BYTES = (size_t)M * EV_IN * 2;
constexpr size_t WS_X1 = al256(WS_BIG + BIG_BYTES), WS_X2 = WS_X1 + (size_t)M * 4 * 4;
constexpr size_t WS_END = WS_X2 + (size_t)M * 4 * 4;
static_assert((size_t)M * (OD_INP + DQN) * 2 <= BIG_BYTES && (size_t)M * DFF * 2 <= BIG_BYTES, "BIG region");
static_assert(CFG_B != 16 || CFG_S != 2048 || WS_END <= (size_t)512 * MiB, "workspace must fit 512 MiB");

constexpr size_t DO_UP = (size_t)M * D * 2;
constexpr size_t DO_WK = DO_UP, DO_WV = DO_WK + (size_t)DEPTH * 512 * D * 2, DO_KB = DO_WV + (size_t)DEPTH * 512 * D * 2, DO_VT = DO_KB + (size_t)MM * DEPTH * 512 * 2, DO_END = DO_VT + (size_t)MM * DEPTH * 512 * 2;
static_assert(CFG_B != 16 || CFG_S != 2048 || DO_END <= (size_t)M * D * 4, "upper half of d_out");
#define DOP(off) ((bf16_t*)((unsigned char*)C.X + (off)))

#define XB_TMO      128
#define XB_XCNT(j)  (256  + 64 * (j))
#define XB_XSUB(j)  (1280 + 64 * (j))
#define XB_XGEN(j)  (2304 + 64 * (j))
#define XB_TOP      3328
#define XB_TOPGEN   3392
#define XCD_BAR_WORDS 3456
#define XB_SPIN_CAP (1u << 22)
#define XB_SPIN(cond, bar) do { unsigned _sp = 0; while (cond) { s_sleep1(); \
    if ((++_sp & 255u) == 0u) { if (atom_ld(&(bar)[XB_TMO])) break; if (_sp > XB_SPIN_CAP) { atom_add(&(bar)[XB_TMO], 1u); break; } } } } while (0)
struct XcdBarrier { unsigned* bar; unsigned x; volatile LAS unsigned* st; };
__device__ __forceinline__ XcdBarrier xcd_barrier_post(unsigned* bar, volatile LAS unsigned* st) {
    XcdBarrier b; b.bar = bar; b.x = xcc_id(); b.st = st;
    if (threadIdx.x == 0) (void)atom_add(&bar[XB_XCNT(b.x)], 1u);
    return b;
}
__device__ __forceinline__ void xcd_barrier_complete(unsigned* bar, unsigned x, unsigned& nloc, unsigned& nx) {
    const unsigned G = gridDim.x;
    unsigned sum, cnt, mine, sp = 0u;
    for (;;) {
        sum = 0u; cnt = 0u; mine = 0u;
#pragma unroll
        for (unsigned j = 0; j < 16; ++j) { const unsigned c = atom_ld(&bar[XB_XCNT(j)]); sum += c; cnt += (c > 0u) ? 1u : 0u; mine = (j == x) ? c : mine; }
        if (sum == G) break;
        s_sleep1();
        if ((++sp & 255u) == 0u) { if (atom_ld(&bar[XB_TMO])) break; if (sp > XB_SPIN_CAP) { atom_add(&bar[XB_TMO], 1u); break; } }
    }
    nloc = mine > 0u ? mine : 1u; nx = cnt > 0u ? cnt : 1u;
}
__device__ __forceinline__ void xcd_barrier(const XcdBarrier& b, const int tid) {
    WAIT_VM(0);
    SYNC();
    if (tid == 0) {
        unsigned* bar = b.bar;
        WAIT_ALL();
        unsigned nloc = b.st[0], nx = b.st[1];
        if (nloc == 0u) { xcd_barrier_complete(bar, b.x, nloc, nx); b.st[0] = nloc; b.st[1] = nx; }
        const unsigned old = atom_add(&bar[XB_XSUB(b.x)], 1u);
        const unsigned gen = old / nloc;
        if (old + 1u == (gen + 1u) * nloc) {
            fence_release();
            WAIT_VM(0);
            const unsigned og = atom_add(&bar[XB_TOP], 1u);
            const unsigned tg = og / nx;
            if (og + 1u == (tg + 1u) * nx) atom_add(&bar[XB_TOPGEN], 1u);
            else XB_SPIN(atom_ld(&bar[XB_TOPGEN]) == tg, bar);
            fence_acquire();
            atom_add(&bar[XB_XGEN(b.x)], 1u);
            WAIT_VM(0);
        } else {
            XB_SPIN(atom_ld(&bar[XB_XGEN(b.x)]) == gen, bar);
            fence_acquire();
            WAIT_VM(0);
        }
    }
    SYNC();
}

namespace pg8 {
constexpr int BM = 256, BK = 64, HALF = 128, HTB = HALF * BK * 2, STAGE_BYTES = 8 * HTB, NXCD = 8, WGM = 8;
__host__ __device__ __forceinline__ int lds_byte(int r, int c) { const int st = (r >> 4) * 2 + (c >> 5), rr = r & 15, cc = c & 31, ob = rr * 64 + cc * 2; return st * 1024 + (ob ^ (((ob >> 9) & 1) << 5)); }
__host__ __device__ __forceinline__ void stage_rc(int b, int& R, int& C) { const int st = b / 1024, sb = b % 1024, swz = sb ^ (((sb >> 9) & 1) << 5); R = (st >> 1) * 16 + swz / 64; C = (st & 1) * 32 + (swz % 64) / 2; }
__host__ __device__ __forceinline__ int perm32(int rho) { const int n = rho >> 4, i = rho & 15; return 8 * (i >> 2) + 4 * n + (i & 3); }
struct Unit { int pm, pn; };
struct Gemm { const bf16_t* A; const bf16_t* Bt; int M, N, K; };
struct StaticOrder {
    int nM, nN, nwg, G, c, i0, imax;
    __host__ __device__ void init(int M_, int N_, int G_, int c_) { nM = M_ / BM; nN = N_ / BM; nwg = nM * nN; G = G_; c = c_; i0 = 0; imax = 1 << 30; }
    __host__ __device__ bool next(int i, Unit& u) const {
        if (i >= imax) return false;
        const long L = (long)(i + i0) * G + c; if (L >= nwg) return false;
        int wgid = (int)L; { const int q = nwg / NXCD, r = nwg % NXCD, xcd = wgid % NXCD, off = wgid / NXCD; wgid = (xcd < r ? xcd * (q + 1) : r * (q + 1) + (xcd - r) * q) + off; }
        const int nig = WGM * nN, gid = wgid / nig, fm = gid * WGM, gsz = (nM - fm) < WGM ? (nM - fm) : WGM;
        u.pm = fm + ((wgid % nig) % gsz); u.pn = (wgid % nig) / gsz; return true;
    }
};
struct EpiBf16 {
    static constexpr bool FUSED = false;
    bf16_t* O; int ldc; const float* rs;
    __device__ __forceinline__ void operator()(const f32x4 (&acc)[2][2][4][2], const Unit& u, int wr, int wc, int fr, int fq) const {
        const int row0 = u.pm * BM + wr * 64 + fr, col0 = u.pn * BM + wc * 32 + 8 * fq;
#pragma unroll
        for (int ai = 0; ai < 2; ++ai)
#pragma unroll
            for (int m = 0; m < 4; ++m) { const int row = row0 + ai * HALF + m * 16; bf16_t* rowp = O + (size_t)row * ldc + col0;
#pragma unroll
                for (int bj = 0; bj < 2; ++bj) { const f32x4 v0 = acc[ai][bj][m][0], v1 = acc[ai][bj][m][1];
                    u32x4 w; w.x = pk2(v0[0], v0[1]); w.y = pk2(v0[2], v0[3]); w.z = pk2(v1[0], v1[1]); w.w = pk2(v1[2], v1[3]);
                    *(u32x4*)(rowp + bj * HALF) = w; } }
    }
};
struct EpiSwiGLU {
    static constexpr bool FUSED = false;
    bf16_t* O; int ldc; const float* rs;
    __device__ __forceinline__ void operator()(const f32x4 (&acc)[2][2][4][2], const Unit& u, int wr, int wc, int fr, int fq) const {
        const int row0 = u.pm * BM + wr * 64 + fr, col0 = u.pn * HALF + wc * 32 + 8 * fq;
        f32x2 one2 = {1.f, 1.f}; LAUNDER_V(one2); const f32x4 one4 = {one2.x, one2.y, one2.x, one2.y};
#pragma unroll
        for (int ai = 0; ai < 2; ++ai)
#pragma unroll
            for (int m = 0; m < 4; ++m) { const int row = row0 + ai * HALF + m * 16; bf16_t* rowp = O + (size_t)row * ldc + col0;
                float o[8];
#pragma unroll
                for (int n = 0; n < 2; ++n) { const f32x4 g4 = acc[ai][0][m][n], u4 = acc[ai][1][m][n]; f32x4 e4 = g4 * -1.4426950408889634f, r4;
#pragma unroll
                    for (int j = 0; j < 4; ++j) e4[j] = fexp2(e4[j]);
                    e4 = e4 + one4;
#pragma unroll
                    for (int j = 0; j < 4; ++j) r4[j] = frcp(e4[j]);
                    const f32x4 o4 = (g4 * u4) * r4;
#pragma unroll
                    for (int j = 0; j < 4; ++j) o[n * 4 + j] = o4[j]; }
                u32x4 w; w.x = pk2(o[0], o[1]); w.y = pk2(o[2], o[3]); w.z = pk2(o[4], o[5]); w.w = pk2(o[6], o[7]);
                *(u32x4*)rowp = w; }
    }
};

#ifdef EMU
#define FUSED_SPIN_CAP 0xfffffff0u
#else
#define FUSED_SPIN_CAP (1u << 22)
#endif
struct EpiFused {
    static constexpr bool FUSED = true;
    bf16_t* XB; const float* g; float scale; float* RS; float* outf; float* X1; float* X2; unsigned* cnt; unsigned want; unsigned* tmo;
    __device__ __forceinline__ void operator()(const f32x4 (&)[2][2][4][2], const Unit&, int, int, int, int) const {}
    __device__ __forceinline__ void exchange(LAS float* P, LAS float* S, float* X, unsigned* cw, const Unit& u, int tid, bool is_rstd_out) const {
        const int row = tid & 255;
        if (tid < 256) { const f32x4 p = *(const LAS f32x4*)(P + row * 4); const float part = (p[0] + p[1]) + (p[2] + p[3]);
#ifdef EMU
            X[((size_t)u.pm * 256 + row) * 4 + u.pn] = part;
#else
            __hip_atomic_store((unsigned*)(X + ((size_t)u.pm * 256 + row) * 4 + u.pn), __builtin_bit_cast(unsigned, part), __ATOMIC_RELAXED, __HIP_MEMORY_SCOPE_AGENT);
#endif
            WAIT_VM(0);
            if ((tid & 63) == 0) atom_add(cw, 1u); }
        if (tid < 64) { unsigned sp = 0;
            while ((unsigned)rfl((int)atom_ld(cw)) < want) { s_sleep1(); if ((++sp & 1023u) == 0u) { if (atom_ld(tmo)) break; if (sp > FUSED_SPIN_CAP) { atom_add(tmo, 1u); break; } } }
            fence_acquire(); WAIT_VM(0); }
        SYNC();
        if (tid < 256) {
#ifdef EMU
            const float* xp = X + ((size_t)u.pm * 256 + row) * 4; const float tot = (xp[0] + xp[1]) + (xp[2] + xp[3]);
#else
            const unsigned* xp = (const unsigned*)(X + ((size_t)u.pm * 256 + row) * 4); float tot = 0.f;
#pragma unroll
            for (int q = 0; q < 4; ++q) tot += __builtin_bit_cast(float, __hip_atomic_load(xp + q, __ATOMIC_RELAXED, __HIP_MEMORY_SCOPE_AGENT));
#endif
            const float r = frsq(tot * (1.f / 1024.f) + 1e-6f); S[row] = r;
            if (is_rstd_out && u.pn == 0) RS[(size_t)u.pm * 256 + row] = frcp(r); }
        SYNC();
    }
    __device__ __forceinline__ void fused(f32x4 (&acc)[2][2][4][2], const Unit& u, int wr, int wc, int fr_, int fq_, LAS unsigned char* lds, int tid_) const {
        int tid = tid_; LAUNDER_V(tid);
        const int fr = tid & 15, fq = (tid & 63) >> 4; (void)fr_; (void)fq_;
        LAS float* P = (LAS float*)lds; LAS float* S = P + 1024;
#pragma unroll
        for (int ai = 0; ai < 2; ++ai)
#pragma unroll
            for (int m = 0; m < 4; ++m) { float q = 0.f;
#pragma unroll
                for (int bj = 0; bj < 2; ++bj)
#pragma unroll
                    for (int n = 0; n < 2; ++n) { const f32x4 v = acc[ai][bj][m][n]; q += (v[0] * v[0] + v[1] * v[1]) + (v[2] * v[2] + v[3] * v[3]); }
                q = xr32_sum(xr16_sum(q)); if (fq == 0) P[(ai * HALF + wr * 64 + m * 16 + fr) * 4 + wc] = q; }
        const int col0 = u.pn * BM + wc * 32 + 8 * fq;
        u32x4 xwv[4][2]; float sov[2][4];
#pragma unroll
        for (int ai = 0; ai < 2; ++ai)
#pragma unroll
            for (int m = 0; m < 4; ++m) { const size_t row = (size_t)u.pm * BM + ai * HALF + wr * 64 + m * 16 + fr; sov[ai][m] = RS[row];
                if (ai == 0) {
#pragma unroll
                    for (int bj = 0; bj < 2; ++bj) xwv[m][bj] = *(const u32x4*)(XB + row * 1024 + col0 + bj * HALF); } }
        SYNC();
        exchange(P, S, X1, cnt + (size_t)u.pm * 64, u, tid, false);
        float gv[2][8];
#pragma unroll
        for (int bj = 0; bj < 2; ++bj) { const f32x4 a = *(const f32x4*)(g + col0 + bj * HALF), b2 = *(const f32x4*)(g + col0 + bj * HALF + 4);
#pragma unroll
            for (int k = 0; k < 4; ++k) { gv[bj][k] = a[k] * scale; gv[bj][4 + k] = b2[k] * scale; } }
#pragma unroll
        for (int ai = 0; ai < 2; ++ai)
#pragma unroll
            for (int m = 0; m < 4; ++m) { const int rl = ai * HALF + wr * 64 + m * 16 + fr; const size_t row = (size_t)u.pm * BM + rl; const float rh = S[rl], so = sov[ai][m]; float q = 0.f;
#pragma unroll
                for (int bj = 0; bj < 2; ++bj) { const u32x4 xw = (ai == 0) ? xwv[m][bj] : *(const u32x4*)(XB + row * 1024 + col0 + bj * HALF); float xv[8];
#pragma unroll
                    for (int k = 0; k < 4; ++k) { xv[2 * k] = bflo(xw[k]) * so; xv[2 * k + 1] = bfhi(xw[k]) * so; }
#pragma unroll
                    for (int n = 0; n < 2; ++n)
#pragma unroll
                        for (int j = 0; j < 4; ++j) { const float nv = xv[4 * n + j] + acc[ai][bj][m][n][j] * rh * gv[bj][4 * n + j]; acc[ai][bj][m][n][j] = nv; q += nv * nv; }
                    if (outf) { float* op = outf + row * 1024 + col0 + bj * HALF; *(f32x4*)op = acc[ai][bj][m][0]; *(f32x4*)(op + 4) = acc[ai][bj][m][1]; } }
                q = xr32_sum(xr16_sum(q)); if (fq == 0) P[rl * 4 + wc] = q; }
        if (outf) return;
        SYNC();
        exchange(P, S, X2, cnt + (size_t)(128 + u.pm) * 64, u, tid, true);
#pragma unroll
        for (int ai = 0; ai < 2; ++ai)
#pragma unroll
            for (int m = 0; m < 4; ++m) { const int rl = ai * HALF + wr * 64 + m * 16 + fr; const size_t row = (size_t)u.pm * BM + rl; const float rn = S[rl];
#pragma unroll
                for (int bj = 0; bj < 2; ++bj) { const f32x4 v0 = acc[ai][bj][m][0] * rn, v1 = acc[ai][bj][m][1] * rn;
                    u32x4 w; w.x = pk2(v0[0], v0[1]); w.y = pk2(v0[2], v0[3]); w.z = pk2(v1[0], v1[1]); w.w = pk2(v1[2], v1[3]); *(u32x4*)(XB + row * 1024 + col0 + bj * HALF) = w; } }
    }
};

template <class Epi>
__device__ __forceinline__ void gemm_phase(LAS unsigned char* lds, const Gemm g, const StaticOrder& S, const Epi& E, const int tid) {
    const int wid = rfl(tid >> 6), lane = tid & 63, wr = wid >> 2, wc = wid & 3, fr = lane & 15, fq = lane >> 4;
    const int K = g.K, nt = K / BK;
    unsigned voffA[2], voffB[2];
#pragma unroll
    for (int i = 0; i < 2; ++i) { int R, C; stage_rc(tid * 16 + i * 8192, R, C); const int Rb = (R & ~31) + perm32(R & 31);
        voffA[i] = (unsigned)(R * K + C) * 2u; voffB[i] = (unsigned)(Rb * K + C) * 2u; }
    const size_t kstep = (size_t)(BK * 2);
    const size_t hstep = (size_t)HALF * K * 2;
    const size_t tstep = 2 * hstep;
    const unsigned ldsw = (unsigned)wid * 1024u;
    const int aoff = lds_byte(wr * 64 + fr, fq * 8), boff = lds_byte(wc * 32 + fr, fq * 8);
#define PG8_SA(b, h) (((b) * 2 + (h)) * HTB)
#define PG8_SB(b, h) ((4 + (b) * 2 + (h)) * HTB)
#define PG8_STAGE(bufoff, gbase, voff) do { _Pragma("unroll") for (int _i = 0; _i < 2; ++_i) \
        glds16((const char*)(gbase) + (voff)[_i], lds + (bufoff) + ldsw + _i * 8192); } while (0)
#define PG8_LDA(dst, b, h) do { _Pragma("unroll") for (int m = 0; m < 4; ++m) _Pragma("unroll") for (int k = 0; k < 2; ++k) dst[m][k] = *(const LAS bf16x8*)(lds + PG8_SA(b, h) + aoff + m * 2048 + k * 1024); } while (0)
#define PG8_LDB(dst, b, h) do { _Pragma("unroll") for (int n = 0; n < 2; ++n) _Pragma("unroll") for (int k = 0; k < 2; ++k) dst[n][k] = *(const LAS bf16x8*)(lds + PG8_SB(b, h) + boff + n * 2048 + k * 1024); } while (0)
#define PG8_MMA(ai, bj, At, Bt) do { SETPRIO(1); _Pragma("unroll") for (int m = 0; m < 4; ++m) _Pragma("unroll") for (int n = 0; n < 2; ++n) _Pragma("unroll") for (int k = 0; k < 2; ++k) \
        acc[ai][bj][m][n] = mfma16(Bt[n][k], At[m][k], acc[ai][bj][m][n]); SETPRIO(0); } while (0)
#define PG8_BAR S_BARRIER()
#define PG8_SCHED SCHED_FENCE()
    Unit cur, nxt; int ui = 0;
    if (!S.next(0, cur)) return;
    f32x4 acc[2][2][4][2];
#pragma unroll
    for (int a = 0; a < 2; ++a)
#pragma unroll
        for (int b = 0; b < 2; ++b)
#pragma unroll
            for (int m = 0; m < 4; ++m)
#pragma unroll
                for (int n = 0; n < 2; ++n) acc[a][b][m][n] = (f32x4){0.f, 0.f, 0.f, 0.f};
    bf16x8 At[4][2], B0[2][2], B1[2][2];
    const char* cA = (const char*)g.A + (size_t)cur.pm * tstep; const char* cB = (const char*)g.Bt + (size_t)cur.pn * tstep;
    PG8_STAGE(PG8_SB(0, 0), cB, voffB); PG8_STAGE(PG8_SB(0, 1), cB + hstep, voffB); PG8_STAGE(PG8_SA(0, 0), cA, voffA); PG8_STAGE(PG8_SA(0, 1), cA + hstep, voffA);
    if (wr == 1) PG8_BAR;
    WAIT_VM(2); PG8_BAR;
    PG8_STAGE(PG8_SB(1, 0), cB + kstep, voffB); PG8_STAGE(PG8_SA(1, 0), cA + kstep, voffA); PG8_STAGE(PG8_SB(1, 1), cB + hstep + kstep, voffB);
    WAIT_VM(6); PG8_BAR;
    for (;;) {
        const bool has_next = S.next(ui + 1, nxt);
        const char* nA = has_next ? (const char*)g.A + (size_t)nxt.pm * tstep : cA; const char* nB = has_next ? (const char*)g.Bt + (size_t)nxt.pn * tstep : cB;
        for (int t = 0; t < nt; t += 2) {
            const bool last = (t == nt - 2);
            const char* a1 = cA + (size_t)(t + 1) * kstep;
            const char* a2 = last ? nA : cA + (size_t)(t + 2) * kstep; const char* b2 = last ? nB : cB + (size_t)(t + 2) * kstep;
            const char* a3 = a2 + kstep; const char* b3 = b2 + kstep;
            PG8_LDB(B0, 0, 0); PG8_LDB(B1, 0, 1); PG8_SCHED; PG8_LDA(At, 0, 0); PG8_STAGE(PG8_SA(1, 1), a1 + hstep, voffA);
            WAIT_VM(8); WAIT_LGKM(0); PG8_BAR; PG8_MMA(0, 0, At, B0); PG8_MMA(0, 1, At, B1); PG8_BAR; PG8_SCHED;
            PG8_LDA(At, 0, 1); PG8_STAGE(PG8_SB(0, 0), b2, voffB); PG8_STAGE(PG8_SB(0, 1), b2 + hstep, voffB); PG8_STAGE(PG8_SA(0, 0), a2, voffA);
            WAIT_VM(8); WAIT_LGKM(0); PG8_BAR; PG8_MMA(1, 0, At, B0); PG8_MMA(1, 1, At, B1); PG8_BAR; PG8_SCHED;
            PG8_LDB(B0, 1, 0); PG8_LDB(B1, 1, 1); PG8_SCHED; PG8_LDA(At, 1, 0); PG8_STAGE(PG8_SA(0, 1), a2 + hstep, voffA);
            WAIT_VM(8); WAIT_LGKM(0); PG8_BAR; PG8_MMA(0, 0, At, B0); PG8_MMA(0, 1, At, B1); PG8_BAR; PG8_SCHED;
            PG8_LDA(At, 1, 1); PG8_STAGE(PG8_SB(1, 0), b3, voffB); PG8_STAGE(PG8_SB(1, 1), b3 + hstep, voffB); PG8_STAGE(PG8_SA(1, 0), a3, voffA);
            WAIT_VM(8); WAIT_LGKM(0); PG8_BAR; PG8_MMA(1, 0, At, B0); PG8_MMA(1, 1, At, B1); PG8_BAR; PG8_SCHED;
        }
        if (wr == 0) PG8_BAR;
        if constexpr (!Epi::FUSED) E(acc, cur, wr, wc, fr, fq);
        if (!has_next) break;
#pragma unroll
        for (int a = 0; a < 2; ++a)
#pragma unroll
            for (int b = 0; b < 2; ++b)
#pragma unroll
                for (int m = 0; m < 4; ++m)
#pragma unroll
                    for (int n = 0; n < 2; ++n) acc[a][b][m][n] = (f32x4){0.f, 0.f, 0.f, 0.f};
        cur = nxt; cA = nA; cB = nB; ++ui;
        if (wr == 1) PG8_BAR;
    }
    WAIT_VM(0);
    PG8_BAR;
    if constexpr (Epi::FUSED) E.fused(acc, cur, wr, wc, fr, fq, lds, tid);
#undef PG8_SA
#undef PG8_SB
#undef PG8_STAGE
#undef PG8_LDA
#undef PG8_LDB
#undef PG8_MMA
#undef PG8_BAR
#undef PG8_SCHED
}
}

enum { I_X = 0, I_MEM, I_NORMG, I_MEMG, I_FGATE, I_FUP, I_FDOWN, I_XAQ, I_XAK, I_XAV, I_XAO, I_EVIN, I_EVOUT,
       I_RWMU, I_RWW0, I_RWW2, I_RWA0, I_RWA2, I_RWG2, I_RWKK, I_RWKA, I_RWRK, I_RWLNG, I_RWLNB, I_RTG, I_RTB,
       I_ODIN, I_ODOUT, I_DQG, I_DKVG, I_DUQ, I_DUK, I_DUV, I_DQI, I_SCW, I_SCB, N_IN };
struct Args { const float* in[N_IN]; float* out; unsigned char* ws; int ph_lo, ph_hi; };

struct InTab {
    LAS unsigned char* lds;
    __device__ __forceinline__ const float* operator[](int k) const { const LAS unsigned* t = (const LAS unsigned*)(lds + LDS_TAB);
        const unsigned lo = (unsigned)rfl((int)t[2 * k]), hi = (unsigned)rfl((int)t[2 * k + 1]); return (const float*)(const GAS float*)(((unsigned long long)hi << 32) | lo); }
};
struct Ctx {
    LAS unsigned char* lds; InTab in; float* X; unsigned char* ws;
    int tid, lane, wave, G, bid;
};
#define WSP(T, off) ((T*)(C.ws + (off)))

__device__ __forceinline__ void tconv(const Ctx& C, const float* W, int K, int N, int ldsrc, bf16_t* WT, int ldd, int grp, int gstride, int goff, int mode) {
    LAS float* scr = (LAS float*)(C.lds + C.wave * 8704);
    const int gw = C.bid * NWAVES + C.wave, NGW = C.G * NWAVES, lane = C.lane;
    const int nblk = (N + 31) / 32, nitems = (K / 64) * nblk;
    for (int item = gw; item < nitems; item += NGW) {
        const int kb = item / nblk, nb = item % nblk, k0 = 64 * kb, n0 = 32 * nb;
        const int nn = n0 + (lane & 31);
#pragma unroll 8
        for (int i = 0; i < 32; ++i) { const int kk = 2 * i + (lane >> 5); scr[kk * 33 + (lane & 31)] = (nn < N) ? W[(size_t)(k0 + kk) * ldsrc + nn] : 0.f; }
        WAIT_LGKM(0); COMPILER_FENCE();
        const int c = lane & 7;
#pragma unroll
        for (int j = 0; j < 4; ++j) { const int nl = (lane >> 3) + 8 * j, n = n0 + nl; const LAS float* s = scr + (8 * c) * 33 + nl;
            u32x4 o; o.x = pk2(s[0 * 33], s[1 * 33]); o.y = pk2(s[2 * 33], s[3 * 33]); o.z = pk2(s[4 * 33], s[5 * 33]); o.w = pk2(s[6 * 33], s[7 * 33]);
            if (n < N) { const int dr = (mode == 1) ? (n < 456 ? n : n + 56) : ((n / grp) * gstride + goff + (n % grp));
                *(u32x4*)(WT + (size_t)dr * ldd + k0 + 8 * c) = o; } }
        WAIT_LGKM(0); COMPILER_FENCE();
    }
}

__device__ __forceinline__ void tconv_tile(const Ctx& C, const float* W, int N, int ldsrc, bf16_t* WT, int ldd, int grp, int gstride, int goff, int mode, int tile, const float* rsc, float cmul = 1.f) {
    LAS float* scr = (LAS float*)C.lds; const int tid = C.tid;
    const int nblk = (N + 127) / 128, kb = tile / nblk, nb = tile % nblk, k0 = 256 * kb, n0 = 128 * nb;
    { const int r = tid >> 5, c4 = (tid & 31) * 4; const bool full = (n0 + c4 + 3 < N);
      f32x4 vv[16];
#pragma unroll
      for (int ps = 0; ps < 16; ++ps) { const int kk = ps * 16 + r; const float* src = W + (size_t)(k0 + kk) * ldsrc + n0 + c4; f32x4 v = {0.f, 0.f, 0.f, 0.f};
          if (full) v = *(const f32x4*)src; else { if (n0 + c4 < N) v[0] = src[0]; if (n0 + c4 + 1 < N) v[1] = src[1]; if (n0 + c4 + 2 < N) v[2] = src[2]; }
          vv[ps] = v; }
#pragma unroll
      for (int ps = 0; ps < 16; ++ps) { const int kk = ps * 16 + r; f32x4 v = vv[ps];
          if (rsc) v = v * (rsc[k0 + kk] * cmul);
          LAS float* d = scr + kk * 129 + c4; d[0] = v[0]; d[1] = v[1]; d[2] = v[2]; d[3] = v[3]; } }
    LSYNC();
    { const int nr = tid >> 5, ksg = tid & 31;
#pragma unroll 2
      for (int ps = 0; ps < 8; ++ps) { const int nl = ps * 16 + nr, n = n0 + nl; const LAS float* sp = scr + (8 * ksg) * 129 + nl;
          u32x4 o; o.x = pk2(sp[0], sp[129]); o.y = pk2(sp[2 * 129], sp[3 * 129]); o.z = pk2(sp[4 * 129], sp[5 * 129]); o.w = pk2(sp[6 * 129], sp[7 * 129]);
          if (n < N) { const int dr = (mode == 1) ? (n < 456 ? n : n + 56) : ((n / grp) * gstride + goff + (n % grp)); *(u32x4*)(WT + (size_t)dr * ldd + k0 + 8 * ksg) = o; } } }
    LSYNC();
}
constexpr int TH_R = 2;
__device__ __forceinline__ void thin_phase(const Ctx& C, const float* xin, const bf16_t* HO, float scale, const float* ga, float* outf) {
    const int gw = C.bid * NWAVES + C.wave, NGW = C.G * NWAVES, lane = C.lane; bf16_t* XB = WSP(bf16_t, WS_XN); float* RS = WSP(float, WS_RSTD);
    float gv[2][8];
    if (!xin) {
#pragma unroll
        for (int j = 0; j < 2; ++j) { const f32x4 a = *(const f32x4*)(ga + 8 * lane + 512 * j), b2 = *(const f32x4*)(ga + 8 * lane + 512 * j + 4);
#pragma unroll
            for (int k = 0; k < 4; ++k) { gv[j][k] = a[k]; gv[j][4 + k] = b2[k]; } } }
    for (int m0 = TH_R * gw; m0 < M; m0 += TH_R * NGW) {
        float v[TH_R][2][8];
        if (xin) {
#pragma unroll
            for (int r = 0; r < TH_R; ++r)
#pragma unroll
                for (int j = 0; j < 2; ++j) { const float* p_ = xin + (size_t)(m0 + r) * D + 8 * lane + 512 * j; const f32x4 a = *(const f32x4*)p_, b2 = *(const f32x4*)(p_ + 4);
#pragma unroll
                    for (int k = 0; k < 4; ++k) { v[r][j][k] = a[k]; v[r][j][4 + k] = b2[k]; } }
        } else {
            u32x4 xw[TH_R][2], hw[TH_R][2];
#pragma unroll
            for (int r = 0; r < TH_R; ++r)
#pragma unroll
                for (int j = 0; j < 2; ++j) { xw[r][j] = *(const u32x4*)(XB + (size_t)(m0 + r) * D + 8 * lane + 512 * j); hw[r][j] = *(const u32x4*)(HO + (size_t)(m0 + r) * D + 8 * lane + 512 * j); }
#pragma unroll
            for (int r = 0; r < TH_R; ++r) { float h[2][8]; float ss = 0.f;
#pragma unroll
                for (int j = 0; j < 2; ++j)
#pragma unroll
                    for (int k = 0; k < 4; ++k) { h[j][2 * k] = bflo(hw[r][j][k]); h[j][2 * k + 1] = bfhi(hw[r][j][k]); v[r][j][2 * k] = bflo(xw[r][j][k]); v[r][j][2 * k + 1] = bfhi(xw[r][j][k]);
                        ss += h[j][2 * k] * h[j][2 * k] + h[j][2 * k + 1] * h[j][2 * k + 1]; }
                const float rr = scale * frsq(wave_sum(ss) * (1.f / D) + EPS);
#pragma unroll
                for (int j = 0; j < 2; ++j)
#pragma unroll
                    for (int k = 0; k < 8; ++k) v[r][j][k] += h[j][k] * gv[j][k] * rr; }
        }
#pragma unroll
        for (int r = 0; r < TH_R; ++r) {
            if (outf) {
#pragma unroll
                for (int j = 0; j < 2; ++j) { float* p_ = outf + (size_t)(m0 + r) * D + 8 * lane + 512 * j;
                    *(f32x4*)p_ = (f32x4){v[r][j][0], v[r][j][1], v[r][j][2], v[r][j][3]}; *(f32x4*)(p_ + 4) = (f32x4){v[r][j][4], v[r][j][5], v[r][j][6], v[r][j][7]}; }
            } else { float ss = 0.f;
#pragma unroll
                for (int j = 0; j < 2; ++j)
#pragma unroll
                    for (int k = 0; k < 8; ++k) ss += v[r][j][k] * v[r][j][k];
                ss = wave_sum(ss); const float rstd = frsq(ss * (1.f / D) + EPS);
#pragma unroll
                for (int j = 0; j < 2; ++j) { u32x4 w;
#pragma unroll
                    for (int k = 0; k < 4; ++k) w[k] = pk2(v[r][j][2 * k] * rstd, v[r][j][2 * k + 1] * rstd);
                    *(u32x4*)(XB + (size_t)(m0 + r) * D + 8 * lane + 512 * j) = w; }
                if (lane == 0) RS[m0 + r] = frcp(rstd); }
        }
    }
}

__device__ __forceinline__ void conv_phase(const Ctx& C, int l, int parts, int vb, int vg) {
    const InTab in = C.in; const int li = l >> 1; const bool even = !(l & 1);
    const int gtid = C.bid * NTHREADS + C.tid, NT = C.G * NTHREADS;
    int gt = vb, toff = 0; const float* ngp = in[I_NORMG] + (size_t)l * 8 * D;
#define TCB(W_, K_, N_, LDS_, WT_, LDD_, GRP_, GST_, GOF_, MODE_, RSC_, ...) do { const int nt_ = ((K_) / 256) * (((N_) + 127) / 128); \
        while (gt < toff + nt_) { tconv_tile(C, (W_), (N_), (LDS_), (WT_), (LDD_), (GRP_), (GST_), (GOF_), (MODE_), gt - toff, (RSC_), ##__VA_ARGS__); gt += vg; } toff += nt_; } while (0)
#pragma unroll 1
    for (int s = 0; s < 2; ++s) if ((parts >> s) & 1) {
        const size_t wofs = ((size_t)l * 2 + s) * D * DFF;
        TCB(in[I_FGATE] + wofs, D, DFF, DFF, WSP(bf16_t, WS_WGU) + (size_t)s * NGU * D, D, 128, 256, 0, 0, ngp + (s ? 6 : 0) * D);
        TCB(in[I_FUP] + wofs, D, DFF, DFF, WSP(bf16_t, WS_WGU) + (size_t)s * NGU * D, D, 128, 256, 128, 0, ngp + (s ? 6 : 0) * D);
        TCB(in[I_FDOWN] + wofs, DFF, D, D, WSP(bf16_t, WS_WDN) + (size_t)s * D * DFF, DFF, D, 0, 0, 0, nullptr);
    }
    if (parts & 1) {
        if (even) TCB(in[I_EVIN] + (size_t)li * D * EV_IN, D, EV_IN, EV_IN, WSP(bf16_t, WS_WIN), D, EV_IN, 0, 0, 0, ngp + 2 * D);
        else { TCB(in[I_ODIN] + (size_t)li * D * 1992, D, 1992, 1992, WSP(bf16_t, WS_WIN), D, 1, 0, 0, 1, ngp + 2 * D);
            bf16_t* z = WSP(bf16_t, WS_WIN) + (size_t)456 * D; for (int i = vb * NTHREADS + C.tid; i < 56 * D; i += vg * NTHREADS) z[i] = 0; } }
    if (parts & 2) {
    TCB(in[I_XAQ] + (size_t)l * D * 512, D, 512, 512, WSP(bf16_t, WS_WQ), D, 512, 0, 0, 0, ngp + 4 * D, 0.12751743f);
    if (l == 0) {
#pragma unroll 1
        for (int ll = 0; ll < DEPTH; ++ll) {
            TCB(in[I_XAK] + (size_t)ll * D * 512, D, 512, 512, DOP(DO_WK) + (size_t)ll * 512 * D, D, 512, 0, 0, 0, nullptr);
            TCB(in[I_XAV] + (size_t)ll * D * 512, D, 512, 512, DOP(DO_WV) + (size_t)ll * 512 * D, D, 512, 0, 0, 0, nullptr); } }
    TCB(in[I_XAO] + (size_t)l * 512 * D, 512, D, D, WSP(bf16_t, WS_WO), 512, D, 0, 0, 0, nullptr);
    if (even) {
        TCB(in[I_EVOUT] + (size_t)li * D * D, D, D, D, WSP(bf16_t, WS_WOUT), D, D, 0, 0, 0, nullptr);
        tconv(C, in[I_RWW2] + (size_t)li * 64 * 512, 64, 512, 512, WSP(bf16_t, WS_W2T), 64, 512, 0, 0, 0);
        tconv(C, in[I_RWA2] + (size_t)li * 64 * 512, 64, 512, 512, WSP(bf16_t, WS_A2T), 64, 512, 0, 0, 0);
        tconv(C, in[I_RWG2] + (size_t)li * 128 * 512, 128, 512, 512, WSP(bf16_t, WS_G2T), 128, 512, 0, 0, 0);
    } else {
        const float* wout = in[I_ODOUT] + (size_t)li * D * D;
        TCB(wout + (size_t)512 * D, 512, D, D, WSP(bf16_t, WS_WOUT) + 1024, OD_Y, D, 0, 0, 0, nullptr);
        { const float* wuv = in[I_DUV] + (size_t)li * 8 * 128 * 64; bf16_t* wo = WSP(bf16_t, WS_WOUT);
          for (int idx = gtid; idx < 1024 * 128; idx += NT) { const int n = idx & 1023, hc0 = (idx >> 10) * 8, h = hc0 >> 7; const float* uv = wuv + (size_t)hc0 * 64; float s8[8];
#pragma unroll
              for (int j = 0; j < 8; ++j) s8[j] = 0.f;
#pragma unroll 8
              for (int d = 0; d < 64; ++d) { const float wv = wout[(size_t)(h * 64 + d) * D + n];
#pragma unroll
                  for (int j = 0; j < 8; ++j) s8[j] += uv[j * 64 + d] * wv; }
              u32x4 o; o.x = pk2(s8[0], s8[1]); o.y = pk2(s8[2], s8[3]); o.z = pk2(s8[4], s8[5]); o.w = pk2(s8[6], s8[7]);
              *(u32x4*)(wo + (size_t)n * OD_Y + hc0) = o; } }
        { const float* wuq = in[I_DUQ] + (size_t)li * 256 * 512; const float* wuk = in[I_DUK] + (size_t)li * 8 * 64 * 128; bf16_t* wd = WSP(bf16_t, WS_WDQ);
          for (int idx = gtid; idx < 1024 * 256; idx += NT) { const int r = idx & 255, n = idx >> 8, h = n >> 7, c = n & 127; float s = 0.f;
#pragma unroll 16
              for (int d = 0; d < 64; ++d) s += wuq[(size_t)r * 512 + h * 64 + d] * wuk[(size_t)(h * 64 + d) * 128 + c];
              wd[(size_t)n * 256 + r] = (bf16_t)f2bf(s * 0.18033688f); } }
        TCB(in[I_DQI] + (size_t)li * 256 * 512, 256, 512, 512, WSP(bf16_t, WS_WDQ) + (size_t)1024 * 256, 256, 512, 0, 0, 0, nullptr);
    }
    }
#undef TCB
    if (l == 0) {
        float* rope = WSP(float, WS_ROPE);
        for (int idx = gtid; idx < SEQ * 64; idx += NT) { const int pos = idx >> 6, j = idx & 63;
            const float inv = exp2f(-(float)j * (13.287712379549449f / 64.f));
            const double ang = (double)((float)pos * inv); const double rev = ang * 0.15915494309189535; const float fr = (float)(rev - floor(rev + 0.5)) * 6.283185307179586f;
            rope[2 * idx] = __cosf(fr); rope[2 * idx + 1] = __sinf(fr); }
        const int gw = C.bid * NWAVES + C.wave, NGW = C.G * NWAVES, lane = C.lane;
        for (int m = gw; m < MM; m += NGW) { const float* xr = in[I_MEM] + (size_t)m * D; f32x4 v[4]; float ss = 0.f;
#pragma unroll
            for (int j = 0; j < 4; ++j) { v[j] = *(const f32x4*)(xr + 4 * lane + 256 * j); ss += (v[j][0] * v[j][0] + v[j][1] * v[j][1]) + (v[j][2] * v[j][2] + v[j][3] * v[j][3]); }
            const float r = 1.f / sqrtf(wave_sum(ss) * (1.f / D) + EPS);
#pragma unroll
            for (int j = 0; j < 4; ++j) { const f32x4 g = *(const f32x4*)(in[I_MEMG] + 4 * lane + 256 * j); const f32x4 o = v[j] * g * r;
                u32x2 w; w.x = pk2(o[0], o[1]); w.y = pk2(o[2], o[3]); *(u32x2*)(WSP(bf16_t, WS_MEMN) + (size_t)m * D + 4 * lane + 256 * j) = w; } }
        thin_phase(C, in[I_X], nullptr, 0.f, nullptr, nullptr);
    }
}

constexpr int RW_TC = 32;
__device__ __forceinline__ void rwkv_unit(const Ctx& C, int unit, int li) {
    const InTab in = C.in; const int b = unit >> 3, h = unit & 7, tid = C.tid, lane = C.lane, wave = C.wave, g = lane >> 4;
    const bf16_t* P = WSP(bf16_t, WS_BIG); bf16_t* Y = WSP(bf16_t, WS_Y);
    LAS float* Rl = (LAS float*)(C.lds); LAS float* Wl = Rl + RW_TC * 64; LAS float* Kl = Wl + RW_TC * 64; LAS float* Vl = Kl + RW_TC * 64; LAS float* Al = Vl + RW_TC * 64; LAS float* Bl = Al + RW_TC * 64;
    LAS float* Yl = Bl + RW_TC * 64; LAS float* Gl = Yl + RW_TC * 64; LAS float* RKl = Gl + RW_TC * 64;
    LAS bf16_t* TW = (LAS bf16_t*)(C.lds + 8 * 8192 + 256); LAS bf16_t* XA = TW + RW_TC * 72; LAS bf16_t* XG = XA + RW_TC * 72;
    const float* mu = in[I_RWMU] + (size_t)li * RW_IN;
    const float* w0 = in[I_RWW0] + li * 512 + h * 64; const float* a0 = in[I_RWA0] + li * 512 + h * 64; const float* kkp = in[I_RWKK] + li * 512 + h * 64;
    const float* kap = in[I_RWKA] + li * 512 + h * 64; const float* rkp = in[I_RWRK] + li * 512 + h * 64; const float* lng = in[I_RWLNG] + li * 512 + h * 64; const float* lnb = in[I_RWLNB] + li * 512 + h * 64;
    const int mt = wave >> 2, nt = wave & 3;
    f32x2 S2[4];
#pragma unroll
    for (int j = 0; j < 4; ++j) S2[j] = (f32x2){0.f, 0.f};
    const int tt = tid >> 4, c16 = tid & 15, c4 = c16 * 4;
    const int sv = tid >> 3, ks8 = (tid & 7) * 8;
    u32x2 cw5[5], pw5[5]; u32x4 cwg, pwg;
#define RW_LOAD(T0) do { const int t_ = (T0) + tt; const bf16_t* pr_ = P + ((size_t)b * SEQ + t_) * EV_IN; const bool hp_ = t_ > 0; const bf16_t* pp_ = pr_ - EV_IN; \
        _Pragma("unroll") for (int seg = 0; seg < 5; ++seg) { const int col = (seg < 3 ? seg * 512 + h * 64 : 1536 + (seg - 3) * 64) + c4; cw5[seg] = *(const u32x2*)(pr_ + col); pw5[seg] = (u32x2){0u, 0u}; if (hp_) pw5[seg] = *(const u32x2*)(pp_ + col); } \
        cwg = *(const u32x4*)(pr_ + 1664 + c16 * 8); pwg = (u32x4){0u, 0u, 0u, 0u}; if (hp_) pwg = *(const u32x4*)(pp_ + 1664 + c16 * 8); } while (0)
    RW_LOAD(0);
    for (int t0 = 0; t0 < SEQ; t0 += RW_TC) {
        { float ssq = 0.f; float kkv[4];
#pragma unroll
          for (int seg = 0; seg < 5; ++seg) {
              const int col = (seg < 3 ? seg * 512 + h * 64 : 1536 + (seg - 3) * 64) + c4;
              const u32x2 cw = cw5[seg], pw = pw5[seg];
              const f32x4 muv = *(const f32x4*)(mu + col);
              const float cur[4] = {bflo(cw.x), bfhi(cw.x), bflo(cw.y), bfhi(cw.y)}, prv[4] = {bflo(pw.x), bfhi(pw.x), bflo(pw.y), bfhi(pw.y)};
              float v[4];
#pragma unroll
              for (int j = 0; j < 4; ++j) v[j] = cur[j] + (prv[j] - cur[j]) * muv[j];
              if (seg == 0) { *(LAS f32x4*)(Rl + tt * 64 + c4) = (f32x4){v[0], v[1], v[2], v[3]}; }
              else if (seg == 1) { *(LAS f32x4*)(Kl + tt * 64 + c4) = (f32x4){v[0], v[1], v[2], v[3]};
#pragma unroll
                  for (int j = 0; j < 4; ++j) { kkv[j] = v[j] * kkp[c4 + j]; ssq += kkv[j] * kkv[j]; } }
              else if (seg == 2) { *(LAS f32x4*)(Vl + tt * 64 + c4) = (f32x4){v[0], v[1], v[2], v[3]}; }
              else if (seg == 3) { u32x2 o; o.x = pk2(tanhf(v[0]), tanhf(v[1])); o.y = pk2(tanhf(v[2]), tanhf(v[3])); *(LAS u32x2*)(TW + tt * 72 + c4) = o; }
              else { u32x2 o; o.x = pk2(v[0], v[1]); o.y = pk2(v[2], v[3]); *(LAS u32x2*)(XA + tt * 72 + c4) = o; }
          }
          ssq = sum16d(ssq); const float inv = 1.f / fmaxf(sqrtf(ssq), 1e-12f);
          *(LAS f32x4*)(Al + tt * 64 + c4) = (f32x4){-kkv[0] * inv, -kkv[1] * inv, -kkv[2] * inv, -kkv[3] * inv};
          { const int col = 1664 + c16 * 8; const u32x4 cw = cwg, pw = pwg;
            float o[8];
#pragma unroll
            for (int j = 0; j < 4; ++j) { const float c0 = bflo(cw[j]), c1 = bfhi(cw[j]), p0 = bflo(pw[j]), p1 = bfhi(pw[j]);
                o[2 * j] = sigmoidf_(c0 + (p0 - c0) * mu[col + 2 * j]); o[2 * j + 1] = sigmoidf_(c1 + (p1 - c1) * mu[col + 2 * j + 1]); }
            u32x4 w; w.x = pk2(o[0], o[1]); w.y = pk2(o[2], o[3]); w.z = pk2(o[4], o[5]); w.w = pk2(o[6], o[7]); *(LAS u32x4*)(XG + tt * 136 + c16 * 8) = w; }
        }
        if (t0 + RW_TC < SEQ) RW_LOAD(t0 + RW_TC);
        SYNC();
        {     bf16x8 bw2[2], ba2[2], bg2[4];
          { const int n = h * 64 + nt * 16 + (lane & 15);
#pragma unroll
            for (int ks = 0; ks < 2; ++ks) { bw2[ks] = *(const bf16x8*)(WSP(bf16_t, WS_W2T) + (size_t)n * 64 + ks * 32 + 8 * g); ba2[ks] = *(const bf16x8*)(WSP(bf16_t, WS_A2T) + (size_t)n * 64 + ks * 32 + 8 * g); }
#pragma unroll
            for (int ks = 0; ks < 4; ++ks) bg2[ks] = *(const bf16x8*)(WSP(bf16_t, WS_G2T) + (size_t)n * 128 + ks * 32 + 8 * g); }
          f32x4 aw = {0.f, 0.f, 0.f, 0.f}, aa = aw, ag = aw;
          const int ar = mt * 16 + (lane & 15);
#pragma unroll
          for (int ks = 0; ks < 2; ++ks) { const bf16x8 fa = *(const LAS bf16x8*)(TW + ar * 72 + ks * 32 + 8 * g); aw = mfma16(fa, bw2[ks], aw);
              const bf16x8 fb = *(const LAS bf16x8*)(XA + ar * 72 + ks * 32 + 8 * g); aa = mfma16(fb, ba2[ks], aa); }
#pragma unroll
          for (int ks = 0; ks < 4; ++ks) { const bf16x8 fa = *(const LAS bf16x8*)(XG + ar * 136 + ks * 32 + 8 * g); ag = mfma16(fa, bg2[ks], ag); }
          const int c = nt * 16 + (lane & 15);
#pragma unroll
          for (int i = 0; i < 4; ++i) { const int t = mt * 16 + g * 4 + i;
              const float z = -(w0[c] + aw[i]); const float sp = (z > 20.f) ? z : log1pf(__expf(z)); const float w = -sp - 0.5f;
              Wl[t * 64 + c] = __expf(-__expf(w));
              const float a = sigmoidf_(a0[c] + aa[i]); const float kraw = Kl[t * 64 + c]; const float kkn = -Al[t * 64 + c];
              Bl[t * 64 + c] = kkn * a; Kl[t * 64 + c] = kraw * (1.f + (a - 1.f) * kap[c]); Gl[t * 64 + c] = ag[i]; }
        }
        SYNC();
        { float s = 0.f;
#pragma unroll
          for (int j = 0; j < 4; ++j) s += Rl[tt * 64 + c4 + j] * Kl[tt * 64 + c4 + j] * rkp[c4 + j];
          s = sum16d(s); if (c16 == 0) RKl[tt] = s; }
        { f32x4 op[2][10]; float vv[2];
#define RW_LDS(buf, t) do { op[buf][0] = *(const LAS f32x4*)(Al + (t) * 64 + ks8); op[buf][1] = *(const LAS f32x4*)(Al + (t) * 64 + ks8 + 4); \
              op[buf][2] = *(const LAS f32x4*)(Wl + (t) * 64 + ks8); op[buf][3] = *(const LAS f32x4*)(Wl + (t) * 64 + ks8 + 4); \
              op[buf][4] = *(const LAS f32x4*)(Bl + (t) * 64 + ks8); op[buf][5] = *(const LAS f32x4*)(Bl + (t) * 64 + ks8 + 4); \
              op[buf][6] = *(const LAS f32x4*)(Kl + (t) * 64 + ks8); op[buf][7] = *(const LAS f32x4*)(Kl + (t) * 64 + ks8 + 4); \
              op[buf][8] = *(const LAS f32x4*)(Rl + (t) * 64 + ks8); op[buf][9] = *(const LAS f32x4*)(Rl + (t) * 64 + ks8 + 4); vv[buf] = Vl[(t) * 64 + sv]; } while (0)
#define RW_STEP(buf, t) do { f32x2 sa2 = {0.f, 0.f}; \
              _Pragma("unroll") for (int q = 0; q < 4; ++q) { const f32x2 a2 = {op[buf][q >> 1][2 * (q & 1)], op[buf][q >> 1][2 * (q & 1) + 1]}; sa2 = S2[q] * a2 + sa2; } \
              const float sa = sum8d(sa2.x + sa2.y); const f32x2 sav = {sa, sa}, vvv = {vv[buf], vv[buf]}; f32x2 y2 = {0.f, 0.f}; \
              _Pragma("unroll") for (int q = 0; q < 4; ++q) { const f32x2 w2 = {op[buf][2 + (q >> 1)][2 * (q & 1)], op[buf][2 + (q >> 1)][2 * (q & 1) + 1]}, b2 = {op[buf][4 + (q >> 1)][2 * (q & 1)], op[buf][4 + (q >> 1)][2 * (q & 1) + 1]}, \
                  k2 = {op[buf][6 + (q >> 1)][2 * (q & 1)], op[buf][6 + (q >> 1)][2 * (q & 1) + 1]}, r2 = {op[buf][8 + (q >> 1)][2 * (q & 1)], op[buf][8 + (q >> 1)][2 * (q & 1) + 1]}; \
                  S2[q] = S2[q] * w2 + (sav * b2 + vvv * k2); y2 = S2[q] * r2 + y2; } \
              const float y = sum8d(y2.x + y2.y); if ((tid & 7) == 0) Yl[(t) * 64 + sv] = y; } while (0)
          RW_LDS(0, 0);
#pragma unroll 2
          for (int t = 0; t < RW_TC; t += 2) {
              RW_LDS(1, t + 1);
              RW_STEP(0, t);
              if (t + 2 < RW_TC) RW_LDS(0, t + 2);
              RW_STEP(1, t + 1);
          }
        }
        SYNC();
        { const f32x4 yv = *(const LAS f32x4*)(Yl + tt * 64 + c4);
          const float mean = sum16d((yv[0] + yv[1]) + (yv[2] + yv[3])) * (1.f / 64.f);
          const f32x4 dv = yv - mean; const float var = sum16d((dv[0] * dv[0] + dv[1] * dv[1]) + (dv[2] * dv[2] + dv[3] * dv[3])) * (1.f / 64.f);
          const float rs = 1.f / sqrtf(var + RW_LN_EPS), rk = RKl[tt]; float o[4];
#pragma unroll
          for (int j = 0; j < 4; ++j) o[j] = (dv[j] * rs * lng[c4 + j] + lnb[c4 + j] + rk * Vl[tt * 64 + c4 + j]) * Gl[tt * 64 + c4 + j];
          u32x2 w; w.x = pk2(o[0], o[1]); w.y = pk2(o[2], o[3]);
          *(u32x2*)(Y + ((size_t)b * SEQ + t0 + tt) * D + h * 64 + c4) = w; }
        SYNC();
    }
}

constexpr int RC_L = 16;
__device__ __forceinline__ float tanh_fast(float x) { return 1.f - 2.f * frcp(__expf(2.f * x) + 1.f); }
__device__ __forceinline__ bf16x8 frag2(u32x2 lo, u32x2 hi) { return __builtin_bit_cast(bf16x8, (u32x4){lo.x, lo.y, hi.x, hi.y}); }
__device__ __forceinline__ u32x2 pack4(const f32x4 v) { u32x2 o; o.x = pk2(v[0], v[1]); o.y = pk2(v[2], v[3]); return o; }
__device__ __forceinline__ void rwkv_unit2(const Ctx& C, int unit, int li) {
    const InTab in = C.in; const int b = unit >> 3, h = unit & 7, tid = C.tid, lane = C.lane, wave = C.wave, g = lane >> 4, lr = lane & 15;
    const bf16_t* P = WSP(bf16_t, WS_BIG); bf16_t* Y = WSP(bf16_t, WS_Y);
    constexpr int OPB = 23040;
    LAS unsigned char* L0 = C.lds;
#define OP_AT(p) ((LAS bf16_t*)(L0 + (p) * OPB))
#define OP_RT(p) (OP_AT(p) + 16 * 72)
#define OP_BT(p) (OP_AT(p) + 2 * 16 * 72)
#define OP_KT(p) (OP_AT(p) + 3 * 16 * 72)
#define OP_BTT(p) (OP_AT(p) + 4 * 16 * 72)
#define OP_KTT(p) (OP_BTT(p) + 64 * 24)
#define OP_VTB(p) (OP_BTT(p) + 2 * 64 * 24)
#define OP_GL(p) ((LAS float*)(L0 + (p) * OPB + 18432))
#define OP_GF(p) (OP_GL(p) + 64)
#define OP_RKP(p) (OP_GL(p) + 64 + 1024)
    LAS bf16_t* MsT = (LAS bf16_t*)(L0 + 2 * OPB); LAS bf16_t* TT = MsT + 16 * 24; LAS bf16_t* NRT = TT + 16 * 24; LAS bf16_t* MRT = NRT + 16 * 24;
    LAS bf16_t* TW = MRT + 16 * 24; LAS bf16_t* XA = TW + 16 * 72; LAS bf16_t* XG = XA + 16 * 72;
    LAS float* Yl = (LAS float*)(L0 + 2 * OPB + 12288); LAS float* NF = Yl + 7168; LAS float* GW = NF + 256;   LAS float* Rf = Yl + 1024; LAS float* Kf = Rf + 1024; LAS float* AK = Kf + 1024; LAS float* Vf = AK + 1024;
    const float* mu = in[I_RWMU] + (size_t)li * RW_IN;
    const float* w0 = in[I_RWW0] + li * 512 + h * 64; const float* a0 = in[I_RWA0] + li * 512 + h * 64; const float* kkp = in[I_RWKK] + li * 512 + h * 64;
    const float* kap = in[I_RWKA] + li * 512 + h * 64; const float* rkp = in[I_RWRK] + li * 512 + h * 64; const float* lng = in[I_RWLNG] + li * 512 + h * 64; const float* lnb = in[I_RWLNB] + li * 512 + h * 64;
    const int pw = wave & 3;
    bf16x8 bwa[2], bg2[4];
    { const int n = h * 64 + pw * 16 + lr; const bf16_t* wsel = (wave < 4) ? WSP(bf16_t, WS_W2T) : WSP(bf16_t, WS_A2T);
#pragma unroll
      for (int ks = 0; ks < 2; ++ks) bwa[ks] = *(const bf16x8*)(wsel + (size_t)n * 64 + ks * 32 + 8 * g);
#pragma unroll
      for (int ks = 0; ks < 4; ++ks) bg2[ks] = *(const bf16x8*)(WSP(bf16_t, WS_G2T) + (size_t)n * 128 + ks * 32 + 8 * g); }
    f32x4 zt[4];
#pragma unroll
    for (int i = 0; i < 4; ++i) zt[i] = (f32x4){0.f, 0.f, 0.f, 0.f};
    const int tt = tid >> 5, c32 = tid & 31, c2 = c32 * 2;
    float mu5[5][2], mug[4];
#pragma unroll
    for (int seg = 0; seg < 5; ++seg) { const int col = (seg < 3 ? seg * 512 + h * 64 : 1536 + (seg - 3) * 64) + c2; mu5[seg][0] = mu[col]; mu5[seg][1] = mu[col + 1]; }
#pragma unroll
    for (int j = 0; j < 4; ++j) mug[j] = mu[1664 + c32 * 4 + j];
    const float kk0 = kkp[c2], kk1 = kkp[c2 + 1], lng0 = lng[c2], lng1 = lng[c2 + 1], lnb0 = lnb[c2], lnb1 = lnb[c2 + 1];
    const float w0c = w0[pw * 16 + lr], a0c = a0[pw * 16 + lr], kac = kap[pw * 16 + lr], rkc = rkp[pw * 16 + lr];
    float kk0s, kk1s, lng0s, lng1s, lnb0s, lnb1s, w0cs, a0cs, kacs, rkcs;
    LAS unsigned char* RING = L0 + 100352;
    unsigned doff[2];
#pragma unroll
    for (int j = 0; j < 2; ++j) { const int q = 16 * wave + 8 * j + (lane >> 3), r = q / 7, ln = q % 7; doff[j] = (unsigned)(r * EV_IN + (ln < 3 ? ln * 512 + h * 64 : 1536 + (ln - 3) * 64) + (lane & 7) * 8); }
    const bf16_t* Pb = P + (size_t)b * SEQ * EV_IN;
#define RC_DMA(CI) do { if (wave < 7) { const bf16_t* src_ = Pb + (unsigned)((CI) * RC_L * EV_IN); LAS unsigned char* dst_ = RING + ((CI) % 3) * (16 * 896) + wave * 2048; \
        glds16(src_ + doff[0], dst_); glds16(src_ + doff[1], dst_ + 1024); } } while (0)
#define RC_POST(CI) do { const int pp_ = (CI) & 1; const f32x2 yv = *(const LAS f32x2*)(Yl + tt * 64 + c2); float sm = yv.x + yv.y; sm = xr16_sum(sum16d(sm)); const float mean = sm * (1.f / 64.f); \
        const float d0 = yv.x - mean, d1 = yv.y - mean; float vq = d0 * d0 + d1 * d1; vq = xr16_sum(sum16d(vq)); const float rs = frsq(vq * (1.f / 64.f) + RW_LN_EPS); \
        const LAS float* rp_ = OP_RKP(pp_) + tt; const float rk = (rp_[0] + rp_[16]) + (rp_[32] + rp_[48]); const LAS float* vf_ = Vf + ((CI) % 3) * 1024 + tt * 64 + c2; const LAS float* gf_ = OP_GF(pp_) + tt * 64 + c2; \
        const float o0 = (d0 * rs * lng0s + lnb0s + rk * vf_[0]) * gf_[0], o1 = (d1 * rs * lng1s + lnb1s + rk * vf_[1]) * gf_[1]; \
        *(unsigned*)(Y + ((size_t)b * SEQ + (CI) * RC_L + tt) * D + h * 64 + c2) = pk2(o0, o1); } while (0)
#define RC_LERP(CI) do { float vv[5][2]; unsigned cw5[5], pw5[5]; u32x2 cwg, pwg; \
        { const int s0_ = ((CI) % 3) * 16 + tt; const LAS unsigned char* rw_ = RING + s0_ * 896 + c32 * 4; const LAS unsigned char* rp_ = RING + (s0_ == 0 ? 47 : s0_ - 1) * 896 + c32 * 4; const bool hp_ = ((CI) * RC_L + tt) > 0; \
          _Pragma("unroll") for (int seg = 0; seg < 5; ++seg) { cw5[seg] = *(const LAS unsigned*)(rw_ + seg * 128); pw5[seg] = hp_ ? *(const LAS unsigned*)(rp_ + seg * 128) : 0u; } \
          cwg = *(const LAS u32x2*)(rw_ + 640 + c32 * 4); pwg = hp_ ? *(const LAS u32x2*)(rp_ + 640 + c32 * 4) : (u32x2){0u, 0u}; } \
        _Pragma("unroll") for (int seg = 0; seg < 5; ++seg) { const float c0 = bflo(cw5[seg]), c1 = bfhi(cw5[seg]), p0 = bflo(pw5[seg]), p1 = bfhi(pw5[seg]); vv[seg][0] = c0 + (p0 - c0) * mu5[seg][0]; vv[seg][1] = c1 + (p1 - c1) * mu5[seg][1]; } \
        *(LAS f32x2*)(Rf + tt * 64 + c2) = (f32x2){vv[0][0], vv[0][1]}; *(LAS f32x2*)(Kf + tt * 64 + c2) = (f32x2){vv[1][0], vv[1][1]}; \
        const float k0 = vv[1][0] * kk0s, k1 = vv[1][1] * kk1s; float ssq = k0 * k0 + k1 * k1; ssq = xr16_sum(sum16d(ssq)); const float inv = frsq(fmaxf(ssq, 1e-24f)); \
        *(LAS f32x2*)(AK + tt * 64 + c2) = (f32x2){-k0 * inv, -k1 * inv}; *(LAS f32x2*)(Vf + ((CI) % 3) * 1024 + tt * 64 + c2) = (f32x2){vv[2][0], vv[2][1]}; \
        LAS bf16_t* vtb_ = OP_VTB((CI) & 1); vtb_[c2 * 24 + tt] = (bf16_t)f2bf(vv[2][0]); vtb_[(c2 + 1) * 24 + tt] = (bf16_t)f2bf(vv[2][1]); \
        *(LAS unsigned*)(TW + tt * 72 + c2) = pk2(tanh_fast(vv[3][0]), tanh_fast(vv[3][1])); *(LAS unsigned*)(XA + tt * 72 + c2) = pk2(vv[4][0], vv[4][1]); \
        float o_[4]; _Pragma("unroll") for (int j = 0; j < 2; ++j) { const float c0 = bflo(cwg[j]), c1 = bfhi(cwg[j]), p0 = bflo(pwg[j]), p1 = bfhi(pwg[j]); \
            o_[2 * j] = sigmoidf_(c0 + (p0 - c0) * mug[2 * j]); o_[2 * j + 1] = sigmoidf_(c1 + (p1 - c1) * mug[2 * j + 1]); } \
        u32x2 w_; w_.x = pk2(o_[0], o_[1]); w_.y = pk2(o_[2], o_[3]); *(LAS u32x2*)(XG + tt * 136 + c32 * 4) = w_; } while (0)
#define RC_WPATH(CI) do { const int p_ = (CI) & 1; f32x4 aw = {0.f, 0.f, 0.f, 0.f}; \
        _Pragma("unroll") for (int ks = 0; ks < 2; ++ks) aw = mfma16(*(const LAS bf16x8*)(TW + lr * 72 + ks * 32 + 8 * g), bwa[ks], aw); \
        const int c = pw * 16 + lr; float e[4], cs[4]; \
        _Pragma("unroll") for (int i = 0; i < 4; ++i) { const float z = -(w0cs + aw[i]); const float sp = (z > 20.f) ? z : __logf(1.f + __expf(z)); e[i] = __expf(-sp - 0.5f); cs[i] = e[i] + (i ? cs[i - 1] : 0.f); } \
        const float tot = cs[3]; float ta_, tb_, pa_, pb_; xr16_pair(tot, ta_, tb_); xr32_pair(ta_ + tb_, pa_, pb_);            \
        const float base = ((g & 1) ? ta_ : 0.f) + ((g & 2) ? pa_ : 0.f); \
        _Pragma("unroll") for (int i = 0; i < 4; ++i) { const int t = 4 * g + i; const float cum = base + cs[i]; const float Gt = __expf(-cum); \
            GW[t * 64 + c] = Gt; GW[1024 + t * 64 + c] = __expf(-(cum - e[i])); GW[2048 + t * 64 + c] = __expf(cum); if (g == 3 && i == 3) OP_GL(p_)[c] = Gt; } } while (0)
#define RC_APATH1(CI) do { const int p_ = (CI) & 1; f32x4 aa = {0.f, 0.f, 0.f, 0.f}; \
        _Pragma("unroll") for (int ks = 0; ks < 2; ++ks) aa = mfma16(*(const LAS bf16x8*)(XA + lr * 72 + ks * 32 + 8 * g), bwa[ks], aa); \
        const int c = pw * 16 + lr; \
        _Pragma("unroll") for (int i = 0; i < 4; ++i) { const int t = 4 * g + i; const float alr = sigmoidf_(a0cs + aa[i]); const float kraw = Kf[t * 64 + c]; ap_kkn[i] = -AK[t * 64 + c]; ap_rr[i] = Rf[t * 64 + c]; \
            ap_kfin[i] = kraw * (1.f + (alr - 1.f) * kacs); ap_bt[i] = ap_kkn[i] * alr; \
            float rk = ap_rr[i] * ap_kfin[i] * rkcs; rk = sum16d(rk); if (lr == 0) OP_RKP(p_)[pw * 16 + t] = rk; } } while (0)
#define RC_APATH2(CI) do { const int p_ = (CI) & 1; const int c = pw * 16 + lr; LAS bf16_t* At_ = OP_AT(p_); LAS bf16_t* Rt_ = OP_RT(p_); LAS bf16_t* Bt_ = OP_BT(p_); LAS bf16_t* Kt_ = OP_KT(p_); f32x4 bq, kq; \
        _Pragma("unroll") for (int i = 0; i < 4; ++i) { const int t = 4 * g + i; const float Gt = GW[t * 64 + c], Gp = GW[1024 + t * 64 + c], iG = GW[2048 + t * 64 + c]; \
            const float bt = ap_bt[i] * iG, kt = ap_kfin[i] * iG; bq[i] = bt; kq[i] = kt; \
            At_[t * 72 + c] = (bf16_t)f2bf(-ap_kkn[i] * Gp); Rt_[t * 72 + c] = (bf16_t)f2bf(ap_rr[i] * Gt); Bt_[t * 72 + c] = (bf16_t)f2bf(bt); Kt_[t * 72 + c] = (bf16_t)f2bf(kt); } \
        *(LAS u32x2*)(OP_BTT(p_) + c * 24 + 4 * g) = pack4(bq); *(LAS u32x2*)(OP_KTT(p_) + c * 24 + 4 * g) = pack4(kq); } while (0)
    WAIT_VM(0);
    LAUNDER_V(bwa[0]); LAUNDER_V(bwa[1]); LAUNDER_V(bg2[0]); LAUNDER_V(bg2[1]); LAUNDER_V(bg2[2]); LAUNDER_V(bg2[3]);
#pragma unroll
    for (int seg = 0; seg < 5; ++seg) { LAUNDER_V(mu5[seg][0]); LAUNDER_V(mu5[seg][1]); }
#pragma unroll
    for (int j = 0; j < 4; ++j) LAUNDER_V(mug[j]);
    { float k0_ = kk0, k1_ = kk1, g0_ = lng0, g1_ = lng1, b0_ = lnb0, b1_ = lnb1, w_ = w0c, a_ = a0c, ka_ = kac, rk_ = rkc;
      LAUNDER_V(k0_); LAUNDER_V(k1_); LAUNDER_V(g0_); LAUNDER_V(g1_); LAUNDER_V(b0_); LAUNDER_V(b1_); LAUNDER_V(w_); LAUNDER_V(a_); LAUNDER_V(ka_); LAUNDER_V(rk_);
      kk0s = k0_; kk1s = k1_; lng0s = g0_; lng1s = g1_; lnb0s = b0_; lnb1s = b1_; w0cs = w_; a0cs = a_; kacs = ka_; rkcs = rk_; }
#define RC_GATE(CI) do { f32x4 ag = {0.f, 0.f, 0.f, 0.f}; _Pragma("unroll") for (int ks = 0; ks < 4; ++ks) ag = mfma16(*(const LAS bf16x8*)(XG + lr * 136 + ks * 32 + 8 * g), bg2[ks], ag); \
        _Pragma("unroll") for (int i = 0; i < 4; ++i) OP_GF((CI) & 1)[(4 * g + i) * 64 + pw * 16 + lr] = ag[i]; } while (0)
    constexpr int NCH = SEQ / RC_L;
    RC_DMA(0); RC_DMA(1); WAIT_VM(0); LSYNC();
#pragma unroll 1
    for (int ci = -1; ci <= NCH; ++ci) {
        const int par = ci & 1;
        if (ci + 1 < NCH) RC_LERP(ci + 1);
        if (ci >= 1) RC_POST(ci - 1);
        LSYNC();
        if (ci + 3 < NCH) RC_DMA(ci + 3);
        if (wave >= 4) { float ap_kkn[4], ap_rr[4], ap_kfin[4], ap_bt[4]; if (ci + 1 < NCH) RC_APATH1(ci + 1); LSYNC(); if (ci + 1 < NCH) RC_APATH2(ci + 1); }
        else if (ci < 0 || ci >= NCH) { if (ci + 1 < NCH) { RC_GATE(ci + 1); RC_WPATH(ci + 1); } LSYNC(); }
        else {
            if (ci + 1 < NCH) { RC_GATE(ci + 1); RC_WPATH(ci + 1); }
            { const LAS bf16_t* Xo = (wave & 1) ? OP_KT(par) : OP_BT(par); const LAS bf16_t* Yo = (wave >> 1) ? OP_RT(par) : OP_AT(par); f32x4 acc = {0.f, 0.f, 0.f, 0.f};
#pragma unroll
              for (int ks = 0; ks < 2; ++ks) acc = mfma16(*(const LAS bf16x8*)(Xo + lr * 72 + ks * 32 + 8 * g), *(const LAS bf16x8*)(Yo + lr * 72 + ks * 32 + 8 * g), acc);
#pragma unroll
              for (int i = 0; i < 4; ++i) { const int j = 4 * g + i; const bool keep = (wave < 2) ? (j < lr) : (j <= lr); acc[i] = keep ? acc[i] : 0.f; }
              if (wave == 0) {
                  *(LAS u32x2*)(TT + lr * 24 + 4 * g) = pack4(acc);
#pragma unroll
                  for (int i = 0; i < 4; ++i) NF[(4 * g + i) * 16 + lr] = acc[i];
              } else { LAS bf16_t* img = (wave == 1) ? MsT : ((wave == 2) ? NRT : MRT); *(LAS u32x2*)(img + lr * 24 + 4 * g) = pack4(acc); } }
            LSYNC();
            { const LAS bf16_t* AtL = OP_AT(par); const LAS bf16_t* RtL = OP_RT(par); const LAS bf16_t* BtT = OP_BTT(par); const LAS bf16_t* KtT = OP_KTT(par); const LAS float* GLf = OP_GL(par);
              const int vrow = wave * 16 + lr; const u32x2 zero2 = {0u, 0u};
              bf16x8 zb[2];
#pragma unroll
              for (int s2 = 0; s2 < 2; ++s2) zb[s2] = frag2(pack4(zt[2 * s2]), pack4(zt[2 * s2 + 1]));
              const u32x2 vfr = *(const LAS u32x2*)(OP_VTB(par) + vrow * 24 + 4 * g);
              f32x4 rhs = {0.f, 0.f, 0.f, 0.f}, yv = rhs;
#pragma unroll
              for (int s2 = 0; s2 < 2; ++s2) { rhs = mfma16(frag2(*(const LAS u32x2*)(AtL + lr * 72 + 32 * s2 + 4 * g), *(const LAS u32x2*)(AtL + lr * 72 + 32 * s2 + 16 + 4 * g)), zb[s2], rhs);
                  yv = mfma16(frag2(*(const LAS u32x2*)(RtL + lr * 72 + 32 * s2 + 4 * g), *(const LAS u32x2*)(RtL + lr * 72 + 32 * s2 + 16 + 4 * g)), zb[s2], yv); }
              rhs = mfma16(frag2(zero2, *(const LAS u32x2*)(MsT + lr * 24 + 4 * g)), frag2(zero2, vfr), rhs);
              const float n01 = NF[(4 * g) * 16 + 4 * g + 1], n02 = NF[(4 * g) * 16 + 4 * g + 2], n03 = NF[(4 * g) * 16 + 4 * g + 3], n12 = NF[(4 * g + 1) * 16 + 4 * g + 2], n13 = NF[(4 * g + 1) * 16 + 4 * g + 3], n23 = NF[(4 * g + 2) * 16 + 4 * g + 3];
              const bf16x8 nsf = frag2(*(const LAS u32x2*)(TT + lr * 24 + 4 * g), zero2);
              f32x4 sa = {0.f, 0.f, 0.f, 0.f};
#pragma unroll
              for (int g0 = 0; g0 < 4; ++g0) { const f32x4 ac = mfma16(nsf, frag2(pack4(sa), zero2), rhs);
                  if (g == g0) { sa[0] = ac[0]; sa[1] = ac[1] + sa[0] * n01; sa[2] = ac[2] + sa[0] * n02 + sa[1] * n12; sa[3] = ac[3] + sa[0] * n03 + sa[1] * n13 + sa[2] * n23; } }
              const bf16x8 svf = frag2(pack4(sa), vfr);
              yv = mfma16(frag2(*(const LAS u32x2*)(NRT + lr * 24 + 4 * g), *(const LAS u32x2*)(MRT + lr * 24 + 4 * g)), svf, yv);
#pragma unroll
              for (int i = 0; i < 4; ++i) Yl[(4 * g + i) * 64 + vrow] = yv[i];
#pragma unroll
              for (int kt = 0; kt < 4; ++kt) { zt[kt] = mfma16(frag2(*(const LAS u32x2*)(BtT + (kt * 16 + lr) * 24 + 4 * g), *(const LAS u32x2*)(KtT + (kt * 16 + lr) * 24 + 4 * g)), svf, zt[kt]);
                  zt[kt] = zt[kt] * *(const LAS f32x4*)(GLf + kt * 16 + 4 * g); } }
        }
        if (ci + 3 < NCH) WAIT_VM(2); else WAIT_VM(0);
        LSYNC();
    }
#undef RC_DMA
#undef RC_POST
#undef RC_LERP
#undef RC_WPATH
#undef RC_APATH1
#undef RC_APATH2
#undef RC_GATE
}

constexpr int RT_LD = 136;
__device__ __forceinline__ void ret_stage_k(const Ctx& C, const bf16_t* P, const float* rope, int b, int h, int t0, LAS bf16_t* KS, bool transposed, float lg2) {
    const int j = C.tid >> 2, dseg = (C.tid & 3) * 16; const size_t m = (size_t)b * SEQ + t0 + j;
    const bf16_t* kr = P + m * EV_IN + RW_IN + 512 + h * 128;
    const float zs = transposed ? exp2f((float)(127 - j) * lg2) * 0.08838834764831845f : 0.08838834764831845f;
    float x1[16], x2[16];
#pragma unroll
    for (int q = 0; q < 2; ++q) { const u32x4 a = *(const u32x4*)(kr + dseg + 8 * q), c = *(const u32x4*)(kr + 64 + dseg + 8 * q);
#pragma unroll
        for (int e = 0; e < 4; ++e) { x1[8 * q + 2 * e] = bflo(a[e]); x1[8 * q + 2 * e + 1] = bfhi(a[e]); x2[8 * q + 2 * e] = bflo(c[e]); x2[8 * q + 2 * e + 1] = bfhi(c[e]); } }
    const float* rp = rope + ((size_t)(t0 + j) * 64 + dseg) * 2;
    float y1[16], y2[16];
#pragma unroll
    for (int e = 0; e < 16; ++e) { const float cs = rp[2 * e], sn = rp[2 * e + 1]; y1[e] = (x1[e] * cs - x2[e] * sn) * zs; y2[e] = (x1[e] * sn + x2[e] * cs) * zs; }
    if (!transposed) {
#pragma unroll
        for (int q = 0; q < 2; ++q) { u32x4 o1, o2;
#pragma unroll
            for (int e = 0; e < 4; ++e) { o1[e] = pk2(y1[8 * q + 2 * e], y1[8 * q + 2 * e + 1]); o2[e] = pk2(y2[8 * q + 2 * e], y2[8 * q + 2 * e + 1]); }
            *(LAS u32x4*)(KS + j * RT_LD + dseg + 8 * q) = o1; *(LAS u32x4*)(KS + j * RT_LD + 64 + dseg + 8 * q) = o2; }
    } else {
#pragma unroll
        for (int e = 0; e < 16; ++e) { KS[(dseg + e) * RT_LD + j] = (bf16_t)f2bf(y1[e]); KS[(64 + dseg + e) * RT_LD + j] = (bf16_t)f2bf(y2[e]); }
    }
}
__device__ __forceinline__ void ret_unit(const Ctx& C, int unit, int li) {
    const InTab in = C.in; const int b = unit >> 2, h = unit & 3, tid = C.tid, lane = C.lane, w = C.wave, g = lane >> 4, lr = lane & 15;
    const bf16_t* P = WSP(bf16_t, WS_BIG); bf16_t* Y = WSP(bf16_t, WS_Y); const float* rope = WSP(float, WS_ROPE);
    LAS bf16_t* KS = (LAS bf16_t*)C.lds; LAS bf16_t* VT = KS + 128 * RT_LD; LAS bf16_t* RT = VT + 128 * RT_LD; LAS bf16_t* PW = RT + 128 * RT_LD + w * (16 * 40);
    const float gx = __builtin_bit_cast(float, (122 - h) << 23);
    const float lg2 = -gx * (1.f + gx * (0.5f + gx * (0.333333333f + gx * (0.25f + gx * (0.2f + gx * 0.166666667f))))) * 1.4426950408889634f;
    const float cg = exp2f(128.f * lg2);
    const float* gg = in[I_RTG] + li * 512 + h * 128; const float* gb = in[I_RTB] + li * 512 + h * 128;
    f32x4 racc[8];
#pragma unroll
    for (int i = 0; i < 8; ++i) racc[i] = (f32x4){0.f, 0.f, 0.f, 0.f};
    for (int n = 0; n < SEQ / 128; ++n) {
        const int t0 = n * 128; const size_t m0 = (size_t)b * SEQ + t0;
        ret_stage_k(C, P, rope, b, h, t0, KS, false, lg2);
        { const int j = tid >> 2, es = (tid & 3) * 32; const bf16_t* vr = P + (m0 + j) * EV_IN + RW_IN + 1024 + h * 128 + es;
#pragma unroll
          for (int q = 0; q < 4; ++q) { const u32x4 a = *(const u32x4*)(vr + 8 * q);
#pragma unroll
              for (int e = 0; e < 4; ++e) { VT[(es + 8 * q + 2 * e) * RT_LD + j] = (bf16_t)(a[e] & 0xffffu); VT[(es + 8 * q + 2 * e + 1) * RT_LD + j] = (bf16_t)(a[e] >> 16); } } }
        bf16x8 qa[4];
        { const int i = 16 * w + lr; const bf16_t* qr = P + (m0 + i) * EV_IN + RW_IN + h * 128; const float* rp = rope + (size_t)(t0 + i) * 128;
          float x[4][8];
#pragma unroll
          for (int ks = 0; ks < 4; ++ks) { const u32x4 a = *(const u32x4*)(qr + 32 * ks + 8 * g);
#pragma unroll
              for (int e = 0; e < 4; ++e) { x[ks][2 * e] = bflo(a[e]); x[ks][2 * e + 1] = bfhi(a[e]); } }
#pragma unroll
          for (int ks = 0; ks < 2; ++ks) {
#pragma unroll
              for (int e = 0; e < 8; ++e) { const int d = 32 * ks + 8 * g + e; const float cs = rp[2 * d], sn = rp[2 * d + 1]; const float a1 = x[ks][e], a2 = x[ks + 2][e];
                  x[ks][e] = a1 * cs - a2 * sn; x[ks + 2][e] = a1 * sn + a2 * cs; } }
#pragma unroll
          for (int ks = 0; ks < 4; ++ks) { u32x4 o;
#pragma unroll
              for (int e = 0; e < 4; ++e) o[e] = pk2(x[ks][2 * e], x[ks][2 * e + 1]);
              qa[ks] = __builtin_bit_cast(bf16x8, o); } }
        SYNC();
        f32x4 oacc[8];
#pragma unroll
        for (int i = 0; i < 8; ++i) oacc[i] = (f32x4){0.f, 0.f, 0.f, 0.f};
        const int npair = (w >> 1) + 1;
        for (int kk = 0; kk < npair; ++kk) {
#pragma unroll
            for (int hf = 0; hf < 2; ++hf) { const int nt = 2 * kk + hf; f32x4 acc = {0.f, 0.f, 0.f, 0.f};
#pragma unroll
                for (int ks = 0; ks < 4; ++ks) acc = mfma16(qa[ks], *(const LAS bf16x8*)(KS + (nt * 16 + lr) * RT_LD + 32 * ks + 8 * g), acc);
#pragma unroll
                for (int r = 0; r < 4; ++r) { const int il = 16 * w + 4 * g + r, jl = nt * 16 + lr; const float v = (il >= jl) ? acc[r] * exp2f((float)(il - jl) * lg2) : 0.f;
                    PW[(4 * g + r) * 40 + hf * 16 + lr] = (bf16_t)f2bf(v); } }
            WAIT_LGKM(0);
            const bf16x8 pa = *(const LAS bf16x8*)(PW + lr * 40 + 8 * g);
#pragma unroll
            for (int nv = 0; nv < 8; ++nv) oacc[nv] = mfma16(pa, *(const LAS bf16x8*)(VT + (nv * 16 + lr) * RT_LD + kk * 32 + 8 * g), oacc[nv]);
        }
        if (n > 0) {
#pragma unroll
            for (int nv = 0; nv < 8; ++nv) { f32x4 c = {0.f, 0.f, 0.f, 0.f};
#pragma unroll
                for (int ks = 0; ks < 4; ++ks) c = mfma16(qa[ks], *(const LAS bf16x8*)(RT + (nv * 16 + lr) * RT_LD + 32 * ks + 8 * g), c);
#pragma unroll
                for (int r = 0; r < 4; ++r) oacc[nv][r] += c[r] * exp2f((float)(16 * w + 4 * g + r + 1) * lg2); }
        }
#pragma unroll
        for (int r = 0; r < 4; ++r) { float s = 0.f;
#pragma unroll
            for (int nv = 0; nv < 8; ++nv) s += oacc[nv][r];
            const float mean = sum16d(s) * (1.f / 128.f); float q = 0.f;
#pragma unroll
            for (int nv = 0; nv < 8; ++nv) { const float d = oacc[nv][r] - mean; q += d * d; }
            const float rs = frsq(sum16d(q) * (1.f / 128.f) + EPS);
            const size_t m = m0 + 16 * w + 4 * g + r; const bf16_t* gr = P + m * EV_IN + RW_IN + 1536 + h * 128;
#pragma unroll
            for (int nv = 0; nv < 8; ++nv) { const int e = nv * 16 + lr; const float gv = bf2f(gr[e]); const float o = (oacc[nv][r] - mean) * rs * gg[e] + gb[e];
                Y[m * D + 512 + h * 128 + e] = (bf16_t)f2bf(gv * sigmoidf_(gv) * o); } }
        SYNC();
        ret_stage_k(C, P, rope, b, h, t0, KS, true, lg2);
        SYNC();
#pragma unroll
        for (int dk = 0; dk < 8; ++dk) { f32x4 c = racc[dk] * cg;
#pragma unroll
            for (int ks = 0; ks < 4; ++ks) c = mfma16(*(const LAS bf16x8*)(VT + (16 * w + lr) * RT_LD + 32 * ks + 8 * g), *(const LAS bf16x8*)(KS + (dk * 16 + lr) * RT_LD + 32 * ks + 8 * g), c);
            racc[dk] = c;
#pragma unroll
            for (int r = 0; r < 4; ++r) RT[(16 * w + 4 * g + r) * RT_LD + dk * 16 + lr] = (bf16_t)f2bf(c[r]); }
        SYNC();
    }
}

__device__ __forceinline__ void dsa_prep_phase(const Ctx& C, int li) {
    const InTab in = C.in; const bf16_t* P = WSP(bf16_t, WS_BIG); const int lane = C.lane;
    const int gw = C.bid * NWAVES + C.wave, NGW = C.G * NWAVES;
    const float* qg = in[I_DQG] + li * 256; const float* kvg = in[I_DKVG] + li * 128;
    constexpr int PR = 4;
    float qgv[4], kgv[2];
#pragma unroll
    for (int k = 0; k < 4; ++k) qgv[k] = qg[4 * lane + k];
    kgv[0] = kvg[2 * lane]; kgv[1] = kvg[2 * lane + 1];
    LAS bf16_t* TT_ = (LAS bf16_t*)C.lds; constexpr int TLD = 66;
    for (int tile = C.bid; tile < M / 64; tile += C.G) {
      for (int hs = 0; hs < 8 / PR; ++hs) { const int m0 = tile * 64 + C.wave * 8 + hs * PR;
        u32x2 av[PR]; unsigned kwv[PR], kiv[PR]; float wiv[PR];
#pragma unroll
        for (int r = 0; r < PR; ++r) { const bf16_t* pr = P + (size_t)(m0 + r) * OD_INP; av[r] = *(const u32x2*)(pr + 4 * lane); kwv[r] = *(const unsigned*)(pr + 256 + 2 * lane);
            kiv[r] = (lane < 32) ? *(const unsigned*)(pr + 384 + 2 * lane) : 0u; wiv[r] = (lane < 8) ? bf2f(pr[448 + lane]) : 0.f; }
#pragma unroll
        for (int r = 0; r < PR; ++r) { const int m = m0 + r;
            const float q[4] = {bflo(av[r].x), bfhi(av[r].x), bflo(av[r].y), bfhi(av[r].y)};
            const float rq = frsq(wave_sum((q[0] * q[0] + q[1] * q[1]) + (q[2] * q[2] + q[3] * q[3])) * (1.f / 256.f) + EPS);
            u32x2 o; o.x = pk2(q[0] * rq * qgv[0], q[1] * rq * qgv[1]); o.y = pk2(q[2] * rq * qgv[2], q[3] * rq * qgv[3]);
            *(u32x2*)(WSP(bf16_t, WS_CQN) + (size_t)m * 256 + 4 * lane) = o;
            const float k0 = bflo(kwv[r]), k1 = bfhi(kwv[r]);
            const float rk = frsq(wave_sum(k0 * k0 + k1 * k1) * (1.f / 128.f) + EPS);
            const unsigned ko = pk2(k0 * rk * kgv[0], k1 * rk * kgv[1]);
            *(unsigned*)(WSP(bf16_t, WS_CKV) + (size_t)m * 128 + 2 * lane) = ko;
            { const int tl = C.wave * 8 + hs * PR + r; TT_[(2 * lane) * TLD + tl] = (bf16_t)(ko & 0xffffu); TT_[(2 * lane + 1) * TLD + tl] = (bf16_t)(ko >> 16); }
            if (lane < 8) WSP(float, WS_WI)[(size_t)m * 8 + lane] = wiv[r] * 0.044194173824159216f;
            if (lane < 32) *(unsigned*)(WSP(bf16_t, WS_KI) + (size_t)m * 64 + 2 * lane) = kiv[r]; }
      }
      LSYNC();
      { const int col = C.tid >> 2, seg = C.tid & 3, bb = (tile * 64) / SEQ, t0 = (tile * 64) % SEQ; const LAS unsigned* src = (const LAS unsigned*)(TT_ + col * TLD + seg * 16); u32x4 a, b2;
        a.x = src[0]; a.y = src[1]; a.z = src[2]; a.w = src[3]; b2.x = src[4]; b2.y = src[5]; b2.z = src[6]; b2.w = src[7];
        bf16_t* ct = WSP(bf16_t, WS_CKVT) + ((size_t)bb * 128 + col) * SEQ + t0 + seg * 16; *(u32x4*)ct = a; *(u32x4*)(ct + 8) = b2; }
      LSYNC();
    }
    const float* cw = in[I_SCW] + (size_t)li * 3 * 512; const float* cb = in[I_SCB] + li * 512; bf16_t* Y = WSP(bf16_t, WS_Y);
    const int gtid = C.bid * NTHREADS + C.tid, NT = C.G * NTHREADS;
    for (int idx = gtid; idx < M * 64; idx += NT) { const int m = idx >> 6, c8 = (idx & 63) * 8, t = m % SEQ; const bf16_t* pr = P + (size_t)m * OD_INP;
        float y[8];
#pragma unroll
        for (int j = 0; j < 8; ++j) y[j] = cb[c8 + j];
#pragma unroll
        for (int k = 0; k < 3; ++k) { const int dt = 2 - k; if (t - dt >= 0) { const bf16_t* pk = pr - (size_t)dt * OD_INP; const u32x4 hh = *(const u32x4*)(pk + 512 + c8), gc = *(const u32x4*)(pk + 1536 + c8);
#pragma unroll
                for (int e = 0; e < 4; ++e) { y[2 * e] += cw[k * 512 + c8 + 2 * e] * bflo(hh[e]) * bflo(gc[e]); y[2 * e + 1] += cw[k * 512 + c8 + 2 * e + 1] * bfhi(hh[e]) * bfhi(gc[e]); } } }
        const u32x4 gbv = *(const u32x4*)(pr + 1024 + c8); u32x4 o;
#pragma unroll
        for (int e = 0; e < 4; ++e) o[e] = pk2(y[2 * e] * bflo(gbv[e]), y[2 * e + 1] * bfhi(gbv[e]));
        *(u32x4*)(Y + (size_t)m * OD_Y + 1024 + c8) = o; }
}

#ifdef EMU
static float* emu_dbg_sc = nullptr;
#endif
constexpr int NU32 = SEQ / 64, UBK = (NU32 < 8) ? NU32 : 8;
__device__ __forceinline__ unsigned sortable(float f) { f = f + 0.0f;     unsigned u; memcpy(&u, &f, 4); return u ^ ((u >> 31) ? 0xffffffffu : 0x80000000u); }
__device__ __forceinline__ void dsa_sel_loadq(const Ctx& C, int b, int pg, bf16x8 (&qf)[4][2], f32x4 (&wq)[4]) {
    const int lane = C.lane, g = lane >> 4, lr = lane & 15, rb0 = 4 * (C.wave >> 2); const size_t mb = (size_t)b * SEQ;
    const bf16_t* QL = WSP(bf16_t, WS_BIG) + (size_t)M * OD_INP; const float* WI = WSP(float, WS_WI);
#pragma unroll
    for (int j = 0; j < 4; ++j) { const size_t mr = mb + 16 * pg + 2 * (rb0 + j); const bf16_t* qr = QL + (mr + (lr >> 3)) * DQN + 1024 + (lr & 7) * 64 + 8 * g;
        qf[j][0] = *(const bf16x8*)qr; qf[j][1] = *(const bf16x8*)(qr + 32);
        wq[j] = *(const f32x4*)(WI + (mr + (g >> 1)) * 8 + 4 * (g & 1)); }
}
__device__ __forceinline__ void dsa_sel_item(const Ctx& C, int b, int pp, LAS float* SC, int tlast, bf16x8 (&qf)[4][2], f32x4 (&wq)[4], bool has_next, int nb, int npg) {
    const int lane = C.lane, g = lane >> 4, lr = lane & 15; const int tA = 2 * pp, tB = tA + 1; const size_t mb = (size_t)b * SEQ, m0 = mb + tA;
    const bf16_t* KI = WSP(bf16_t, WS_KI);
    unsigned long long* MASK = WSP(unsigned long long, WS_MASK);
    { const int w = C.wave, cb = w & 3, rb0 = 4 * (w >> 2);
      WAIT_VM(0);
#pragma unroll
      for (int j = 0; j < 4; ++j) { LAUNDER_V(qf[j][0]); LAUNDER_V(qf[j][1]); LAUNDER_V(wq[j]); }
      RPT(71) { const int n64 = (tlast >> 6) + 1; bf16x8 kq[2][2];
        const bf16_t* kip = KI + (mb + cb * 16 + lr) * 64 + 8 * g;
        kq[0][0] = *(const bf16x8*)kip; kq[0][1] = *(const bf16x8*)(kip + 32); SCHED_FENCE();
        { const unsigned o1 = (unsigned)((n64 > 1 ? 1 : 0) * 64 * 64); kq[1][0] = *(const bf16x8*)(kip + o1); kq[1][1] = *(const bf16x8*)(kip + o1 + 32); } SCHED_FENCE();
        LAS float* scw = SC - w * (2 * SEQ) + (2 * (rb0 + (g & 1)) + (g >> 1)) * SEQ + cb * 16 + lr;
#define SEL_STEP(KT_, SG) do { \
            f32x4 acc[4]; float ps[4]; \
            _Pragma("unroll") for (int j = 0; j < 4; ++j) { acc[j] = mfma16(qf[j][0], kq[SG][0], (f32x4){0.f, 0.f, 0.f, 0.f}); acc[j] = mfma16(qf[j][1], kq[SG][1], acc[j]); } \
            SCHED_FENCE(); __asm__ volatile("" ::: "memory");                                \
            { const unsigned o2 = (unsigned)((((KT_) + 2 < n64) ? (KT_) + 2 : n64 - 1) * 64 * 64); kq[SG][0] = *(const bf16x8*)(kip + o2); kq[SG][1] = *(const bf16x8*)(kip + o2 + 32); } \
            __asm__ volatile("" ::: "memory"); SCHED_FENCE(); \
            _Pragma("unroll") for (int j = 0; j < 4; ++j) { ps[j] = wq[j][0] * fmaxf(acc[j][0], 0.f); \
                _Pragma("unroll") for (int i = 1; i < 4; ++i) ps[j] = fmaf(wq[j][i], fmaxf(acc[j][i], 0.f), ps[j]); } \
            xr16_swap2(ps[0], ps[1]); xr16_swap2(ps[2], ps[3]);                              \
            scw[(KT_) * 64] = ps[0] + ps[1]; scw[4 * SEQ + (KT_) * 64] = ps[2] + ps[3]; } while (0)
        int kt = 0;
        for (; kt + 1 < n64; kt += 2) { SEL_STEP(kt, 0); SEL_STEP(kt + 1, 1); }
        if (kt < n64) SEL_STEP(kt, 0);
#undef SEL_STEP
        WAIT_VM(0); LAUNDER_V(kq[0][0]); LAUNDER_V(kq[0][1]); LAUNDER_V(kq[1][0]); LAUNDER_V(kq[1][1]);
        WAIT_LGKM(0); SYNC(); }
      dsa_sel_loadq(C, nb, npg, qf, wq); }
    WAIT_LGKM(0);
#ifdef EMU
    if (emu_dbg_sc && b == 0) for (int j = lane; j < SEQ; j += 64) { emu_dbg_sc[(size_t)tA * SEQ + j] = SC[j]; emu_dbg_sc[(size_t)tB * SEQ + j] = SC[SEQ + j]; }
#endif
    unsigned u0[NU32], u1[NU32];
#pragma unroll
    for (int i = 0; i < NU32; ++i) { const int j = lane + 64 * i; u0[i] = (j <= tA) ? sortable(SC[j]) : 0u; u1[i] = (j <= tB) ? sortable(SC[SEQ + j]) : 0u; }
    unsigned lo0, hi0, lo1, hi1; bool sep0, sep1;
    RPT(72) { lo0 = 1u; hi0 = 0xffffffffu; lo1 = 1u; hi1 = 0xffffffffu; sep0 = (tA + 1 <= TOPK); sep1 = (tB + 1 <= TOPK);
    bool run0 = !sep0, run1 = !sep1;
    while (run0 || run1) {
        const unsigned mid0 = lo0 + ((hi0 - lo0) >> 1), mid1 = lo1 + ((hi1 - lo1) >> 1); int c0 = 0, c1 = 0;
#pragma unroll
        for (int blk = 0; blk < NU32 / UBK; ++blk) if (blk * UBK <= (tB >> 6)) {
#pragma unroll
            for (int i = blk * UBK; i < blk * UBK + UBK; ++i) { c0 += popc64(ballot64(u0[i] >= mid0)); c1 += popc64(ballot64(u1[i] >= mid1)); } }
        if (run0) { if (c0 == TOPK) { lo0 = mid0; sep0 = true; run0 = false; } else { if (c0 > TOPK) lo0 = mid0; else hi0 = mid0; if (hi0 - lo0 <= 1u) run0 = false; } }
        if (run1) { if (c1 == TOPK) { lo1 = mid1; sep1 = true; run1 = false; } else { if (c1 > TOPK) lo1 = mid1; else hi1 = mid1; if (hi1 - lo1 <= 1u) run1 = false; } }
    } }
    RPT(73)
#pragma unroll
    for (int tok = 0; tok < 2; ++tok) { const int t = tA + tok; const unsigned thr = tok ? lo1 : lo0; const bool sep = tok ? sep1 : sep0; int jcut = SEQ;
        if (!sep) { int cg = 0, ce = 0;
#pragma unroll
            for (int i = 0; i < NU32; ++i) { const unsigned uv = tok ? u1[i] : u0[i]; cg += (uv > thr) ? 1 : 0; ce += (uv == thr) ? 1 : 0; }
            cg = wave_isum(cg); ce = wave_isum(ce); const int need = TOPK - cg;
            if (ce > need) { int J = 0;
                for (int bit = 12; bit >= 0; --bit) { const int cand = J | (1 << bit); int c = 0;
#pragma unroll
                    for (int i = 0; i < NU32; ++i) { const unsigned uv = tok ? u1[i] : u0[i]; c += (uv == thr && (lane + 64 * i) < cand) ? 1 : 0; }
                    if (wave_isum(c) < need) J = cand; }
                jcut = J; } }
        unsigned long long myw = 0ull;
        if (sep) {
#pragma unroll
            for (int blk = 0; blk < NU32 / UBK; ++blk) if (blk * UBK <= (tB >> 6)) {
#pragma unroll
                for (int i = blk * UBK; i < blk * UBK + UBK; ++i) { const unsigned uv = tok ? u1[i] : u0[i]; const unsigned long long bits = ballot64(uv >= thr); setlane64(myw, bits, i, lane); } }
        } else {
#pragma unroll
            for (int i = 0; i < NU32; ++i) { const int j = lane + 64 * i; const unsigned uv = tok ? u1[i] : u0[i];
                const bool sel = (j <= t) && (uv > thr || (uv == thr && j <= jcut)); const unsigned long long bits = ballot64(sel); setlane64(myw, bits, i, lane); } }
        if (lane < NU32) MASK[(m0 + tok) * NU32 + lane] = myw;
    }
}
__device__ __forceinline__ void dsa_select_phase(const Ctx& C) {
    LAS float* SC = (LAS float*)(C.lds + C.wave * (2 * SEQ * 4));
    constexpr int NUN = NB * (SEQ / 16);
    bf16x8 qf[4][2]; f32x4 wq[4]; bool have = false;
    for (int k = 0;; ++k) { const int idx = k * C.G + ((k & 1) ? (C.G - 1 - C.bid) : C.bid); if (idx >= NUN) { if (k * C.G >= NUN) break; else continue; }
        const int pg = idx / NB, b = idx % NB; if (!have) dsa_sel_loadq(C, b, pg, qf, wq);
        const int k2 = k + 1, idx2 = k2 * C.G + ((k2 & 1) ? (C.G - 1 - C.bid) : C.bid); const bool hn = idx2 < NUN;
        dsa_sel_item(C, b, pg * 8 + C.wave, SC, pg * 16 + 15, qf, wq, hn, hn ? idx2 % NB : b, hn ? idx2 / NB : pg); have = hn; SYNC(); }
}

constexpr int DA_KLD = 136, DA_VLD = 72, DA_KBYTES = 64 * DA_KLD * 2, DA_VBYTES = 128 * DA_VLD * 2, DA_BUF = DA_KBYTES + DA_VBYTES;
__device__ __forceinline__ void dsa_attn_unit(const Ctx& C, int b, int qt) {
    const int tid = C.tid, lane = C.lane, w = C.wave, g = lane >> 4, lr = lane & 15; const size_t mb = (size_t)b * SEQ; const int t0 = qt * 32; const size_t m0 = mb + t0;
    const bf16_t* QL = WSP(bf16_t, WS_BIG) + (size_t)M * OD_INP; const bf16_t* CKV = WSP(bf16_t, WS_CKV); const bf16_t* CKVT = WSP(bf16_t, WS_CKVT);
    const unsigned long long* MASK = WSP(unsigned long long, WS_MASK); bf16_t* Y = WSP(bf16_t, WS_Y);
    bf16x8 ql[2][4];
#pragma unroll
    for (int rt = 0; rt < 2; ++rt) { const size_t mrow_ = m0 + 4 * w + 2 * rt + (lr >> 3); const bf16_t* qr = QL + mrow_ * DQN + (lr & 7) * 128;
#pragma unroll
        for (int ks = 0; ks < 4; ++ks) ql[rt][ks] = *(const bf16x8*)(qr + 32 * ks + 8 * g); }
    f32x4 oacc[2][8], minit[2]; float lrun[2];
#pragma unroll
    for (int rt = 0; rt < 2; ++rt) { minit[rt] = (f32x4){0.f, 0.f, 0.f, 0.f}; lrun[rt] = 0.f;
#pragma unroll
        for (int nv = 0; nv < 8; ++nv) oacc[rt][nv] = (f32x4){0.f, 0.f, 0.f, 0.f}; }
    const int nk = (t0 + 31) / 64 + 1;
    const int kr = tid >> 3, kc = (tid & 7) * 16, vr = tid >> 2, vc = (tid & 3) * 16;
    u32x4 sk[2], sv[2];
    const bf16_t* kbase = CKV + mb * 128; const bf16_t* vbase = CKVT + (size_t)b * 128 * SEQ; const unsigned koff = (unsigned)(kr * 128 + kc), voff = (unsigned)(vr * SEQ + vc);
    const unsigned long long* mbase = MASK + m0 * NU32;
#define DA_LOAD(kt) do { const bf16_t* kp = kbase + ((unsigned)((kt) * 64 * 128) + koff); sk[0] = *(const u32x4*)kp; sk[1] = *(const u32x4*)(kp + 8); \
        const bf16_t* vp = vbase + ((unsigned)((kt) * 64) + voff); sv[0] = *(const u32x4*)vp; sv[1] = *(const u32x4*)(vp + 8); } while (0)
#define DA_STORE(buf) do { LAS bf16_t* kd = (LAS bf16_t*)(C.lds + (buf) * DA_BUF) + kr * DA_KLD + kc; *(LAS u32x4*)kd = sk[0]; *(LAS u32x4*)(kd + 8) = sk[1]; \
        LAS bf16_t* vd = (LAS bf16_t*)(C.lds + (buf) * DA_BUF + DA_KBYTES) + vr * DA_VLD + vc; *(LAS u32x4*)vd = sv[0]; *(LAS u32x4*)(vd + 8) = sv[1]; } while (0)
#define DA_KB(i) ((LAS bf16_t*)(C.lds + (i) * DA_KBYTES))
#define DA_VB(j) ((LAS bf16_t*)(C.lds + 2 * DA_KBYTES + (j) * DA_VBYTES))
#undef DA_STORE
#define DA_STORE(kb, vb) do { LAS bf16_t* kd = DA_KB(kb) + kr * DA_KLD + kc; *(LAS u32x4*)kd = sk[0]; *(LAS u32x4*)(kd + 8) = sk[1]; \
        LAS bf16_t* vd = DA_VB(vb) + vr * DA_VLD + vc; *(LAS u32x4*)vd = sv[0]; *(LAS u32x4*)(vd + 8) = sv[1]; } while (0)
    const bool grpB = (w >= 4);
    f32x4 sacc[2][4]; bf16x8 pf[2][2];
#define DA_S(KT) do { _Pragma("unroll") for (int nt = 0; nt < 4; ++nt) { \
        _Pragma("unroll") for (int ks = 0; ks < 4; ++ks) { const bf16x8 kf = *(const LAS bf16x8*)((KT) + (nt * 16 + lr) * DA_KLD + 32 * ks + 8 * g); \
            sacc[0][nt] = mfma16(kf, ql[0][ks], ks ? sacc[0][nt] : minit[0]); sacc[1][nt] = mfma16(kf, ql[1][ks], ks ? sacc[1][nt] : minit[1]); } } } while (0)
#define DA_SM(T, FIRST) do { int lx_ = lane; LAUNDER_V(lx_); const LAS unsigned long long* mwp = MW + ((lx_ >> 3) & 1) * NU32 + (T); float mxr[2]; \
    _Pragma("unroll") for (int rt = 0; rt < 2; ++rt) { float mx = -1e30f; \
        _Pragma("unroll") for (int nt = 0; nt < 4; ++nt) _Pragma("unroll") for (int i = 0; i < 4; ++i) mx = fmaxf(mx, sacc[rt][nt][i]); \
        mxr[rt] = xr32_max(xr16_max(mx)); } \
    if ((FIRST) || ballot64(fmaxf(mxr[0], mxr[1]) > 8.f) != 0ull) { \
        _Pragma("unroll") for (int rt = 0; rt < 2; ++rt) { const float d = (FIRST) ? mxr[rt] : fmaxf(mxr[rt], 0.f); const float al = (FIRST) ? 1.f : fexp2(-d); lrun[rt] *= al; \
            _Pragma("unroll") for (int nv = 0; nv < 8; ++nv) oacc[rt][nv] *= al; \
            _Pragma("unroll") for (int nt = 0; nt < 4; ++nt) sacc[rt][nt] = sacc[rt][nt] - d; \
            const float nr = minit[rt][0] - d; minit[rt] = (f32x4){nr, nr, nr, nr}; } } \
    _Pragma("unroll") for (int rt = 0; rt < 2; ++rt) { const unsigned long long mkv = mwp[rt * 2 * NU32]; float ps = 0.f; unsigned pw[8]; \
        _Pragma("unroll") for (int nt = 0; nt < 4; ++nt) { float pv[4]; const unsigned nib = (unsigned)(mkv >> (nt * 16 + 4 * g)); \
            _Pragma("unroll") for (int i = 0; i < 4; ++i) { pv[i] = __builtin_bit_cast(float, __builtin_bit_cast(int, fexp2(sacc[rt][nt][i])) & bfe_i1(nib, i)); ps += pv[i]; } \
            pw[2 * nt] = pk2(pv[0], pv[1]); pw[2 * nt + 1] = pk2(pv[2], pv[3]); } \
        lrun[rt] += ps; \
        pf[rt][0] = __builtin_bit_cast(bf16x8, (u32x4){pw[0], pw[1], pw[2], pw[3]}); pf[rt][1] = __builtin_bit_cast(bf16x8, (u32x4){pw[4], pw[5], pw[6], pw[7]}); } \
        } while (0)
#define DA_PV(VT) do { _Pragma("unroll") for (int nv = 0; nv < 8; ++nv) _Pragma("unroll") for (int s2 = 0; s2 < 2; ++s2) { const LAS bf16_t* vp = (VT) + (nv * 16 + lr) * DA_VLD + s2 * 32 + 4 * g; \
        const u32x2 lo = *(const LAS u32x2*)vp, hi = *(const LAS u32x2*)(vp + 16); const bf16x8 vf = __builtin_bit_cast(bf16x8, (u32x4){lo.x, lo.y, hi.x, hi.y}); \
        oacc[0][nv] = mfma16(vf, pf[0][s2], oacc[0][nv]); oacc[1][nv] = mfma16(vf, pf[1][s2], oacc[1][nv]); } } while (0)
    DA_LOAD(0); DA_STORE(0, 0);
    LAS unsigned long long* MW = (LAS unsigned long long*)(C.lds + 2 * DA_KBYTES + 3 * DA_VBYTES) + w * (4 * NU32);
    for (int i = lane; i < 4 * NU32; i += 64) MW[i] = mbase[(unsigned)(4 * w * NU32 + i)];
    WAIT_VM(0);
#pragma unroll
    for (int rt = 0; rt < 2; ++rt)
#pragma unroll
        for (int ks = 0; ks < 4; ++ks) LAUNDER_V(ql[rt][ks]);
    SYNC();
    if (!grpB) {
        int vbs = 0;
        for (int st = 0; st <= nk; ++st) {
            if (st + 1 < nk) DA_LOAD(st + 1);
            if (st < nk) { DA_S(DA_KB(st & 1)); DA_SM(st, st == 0); DA_PV(DA_VB(vbs)); }
            const int vbn = (vbs == 2) ? 0 : vbs + 1;
            if (st + 1 < nk) DA_STORE((st + 1) & 1, vbn);
            vbs = vbn;
            SYNC();
        }
    } else {
        int vbs = 0, vbp = 2;
        for (int st = 0; st <= nk; ++st) {
            if (st + 1 < nk) DA_LOAD(st + 1);
            if (st >= 1) DA_PV(DA_VB(vbp));
            if (st < nk) { DA_S(DA_KB(st & 1)); DA_SM(st, st == 0); }
            const int vbn = (vbs == 2) ? 0 : vbs + 1;
            if (st + 1 < nk) DA_STORE((st + 1) & 1, vbn);
            vbp = vbs; vbs = vbn;
            SYNC();
        }
    }
#undef DA_S
#undef DA_SM
#undef DA_PV
#undef DA_KB
#undef DA_VB
#pragma unroll
    for (int rt = 0; rt < 2; ++rt) { float l = xr32_sum(xr16_sum(lrun[rt])); const float inv = 1.f / l;
        int lrb = lr; LAUNDER_V(lrb);
        bf16_t* yr = Y + (m0 + 4 * w + 2 * rt + (lrb >> 3)) * OD_Y + (lrb & 7) * 128 + 4 * g;
#pragma unroll
        for (int nv = 0; nv < 8; ++nv) { u32x2 o; o.x = pk2(oacc[rt][nv][0] * inv, oacc[rt][nv][1] * inv); o.y = pk2(oacc[rt][nv][2] * inv, oacc[rt][nv][3] * inv); *(u32x2*)(yr + nv * 16) = o; } }
#undef DA_LOAD
#undef DA_STORE
}
__device__ __forceinline__ void dsa_attn_phase(const Ctx& C) {
    constexpr int NQT = SEQ / 32, NUN = NB * NQT;
    for (int k = 0;; ++k) { const int idx = k * C.G + ((k & 1) ? (C.G - 1 - C.bid) : C.bid); if (idx >= NUN) { if (k * C.G >= NUN) break; else continue; }
        const int qt = idx / NB, b = idx % NB; dsa_attn_unit(C, b, qt); LSYNC(); }
}

constexpr int XA_Q = (SEQ >= 512) ? 512 : SEQ, XA_KLD = 136, XA_VLD = 264;
__device__ __forceinline__ void xattn_phase(const Ctx& C, int l) {
    const int tid = C.tid, lane = C.lane, w = C.wave, g = lane >> 4, lr = lane & 15;
    const bf16_t* Q = WSP(bf16_t, WS_BIG); bf16_t* AO = WSP(bf16_t, WS_BIG) + (size_t)M * 512; const bf16_t* KB = DOP(DO_KB) + l * 512; const bf16_t* VT = DOP(DO_VT) + (size_t)l * 512 * MM; constexpr int KLD = DEPTH * 512;
    LAS bf16_t* KL = (LAS bf16_t*)C.lds; LAS bf16_t* VL = KL + 256 * XA_KLD;
    constexpr int NQR = SEQ / XA_Q, NUN = NB * 4 * NQR;
    for (int u = C.bid; u < NUN; u += C.G) { const int qr = u % NQR, bh = u / NQR, h = bh & 3, b = bh >> 2;
        { const int j = tid >> 1, hf = (tid & 1) * 64; const bf16_t* kp = KB + ((size_t)b * 256 + j) * KLD + h * 128 + hf; LAS bf16_t* kd = KL + j * XA_KLD + hf;
#pragma unroll
          for (int q = 0; q < 8; ++q) *(LAS u32x4*)(kd + 8 * q) = *(const u32x4*)(kp + 8 * q);
          const int d = tid >> 2, sg = (tid & 3) * 64; const bf16_t* vp = VT + ((size_t)h * 128 + d) * MM + (size_t)b * 256 + sg; LAS bf16_t* vd = VL + d * XA_VLD + sg;
#pragma unroll
          for (int q = 0; q < 8; ++q) *(LAS u32x4*)(vd + 8 * q) = *(const u32x4*)(vp + 8 * q); }
        LSYNC();
        for (int it = 0; it < XA_Q / 256; ++it) {
            const size_t mbase = (size_t)b * SEQ + (size_t)qr * XA_Q + it * 256 + w * 32;
            bf16x8 ql[2][4];
#pragma unroll
            for (int rt = 0; rt < 2; ++rt) { const bf16_t* qp = Q + (mbase + rt * 16 + lr) * 512 + h * 128;
#pragma unroll
                for (int ks = 0; ks < 4; ++ks) ql[rt][ks] = *(const bf16x8*)(qp + 32 * ks + 8 * g); }
            f32x4 oacc[2][8], minit[2]; float lrun[2];
#pragma unroll
            for (int rt = 0; rt < 2; ++rt) { minit[rt] = (f32x4){0.f, 0.f, 0.f, 0.f}; lrun[rt] = 0.f;
#pragma unroll
                for (int nv = 0; nv < 8; ++nv) oacc[rt][nv] = (f32x4){0.f, 0.f, 0.f, 0.f}; }
#pragma unroll 1
            for (int kc = 0; kc < 4; ++kc) {
                f32x4 sacc[2][4];
#pragma unroll
                for (int nt = 0; nt < 4; ++nt) {
#pragma unroll
                    for (int ks = 0; ks < 4; ++ks) { const bf16x8 kf = *(const LAS bf16x8*)(KL + (kc * 64 + nt * 16 + lr) * XA_KLD + 32 * ks + 8 * g);
                        sacc[0][nt] = mfma16(kf, ql[0][ks], ks ? sacc[0][nt] : minit[0]); sacc[1][nt] = mfma16(kf, ql[1][ks], ks ? sacc[1][nt] : minit[1]); } }
                bf16x8 pf[2][2]; float mxr[2];
#pragma unroll
                for (int rt = 0; rt < 2; ++rt) { float mx = -1e30f;
#pragma unroll
                    for (int nt = 0; nt < 4; ++nt)
#pragma unroll
                        for (int i = 0; i < 4; ++i) mx = fmaxf(mx, sacc[rt][nt][i]);
                    mxr[rt] = xr32_max(xr16_max(mx)); }
                if (kc == 0 || ballot64(fmaxf(mxr[0], mxr[1]) > 8.f) != 0ull) {
#pragma unroll
                    for (int rt = 0; rt < 2; ++rt) { const float d = (kc == 0) ? mxr[rt] : fmaxf(mxr[rt], 0.f); const float al = (kc == 0) ? 1.f : fexp2(-d); lrun[rt] *= al;
#pragma unroll
                        for (int nv = 0; nv < 8; ++nv) oacc[rt][nv] *= al;
#pragma unroll
                        for (int nt = 0; nt < 4; ++nt) sacc[rt][nt] = sacc[rt][nt] - d;
                        const float nr = minit[rt][0] - d; minit[rt] = (f32x4){nr, nr, nr, nr}; } }
#pragma unroll
                for (int rt = 0; rt < 2; ++rt) { float ps = 0.f; unsigned pw[8];
#pragma unroll
                    for (int nt = 0; nt < 4; ++nt) { float pv[4];
#pragma unroll
                        for (int i = 0; i < 4; ++i) { pv[i] = fexp2(sacc[rt][nt][i]); ps += pv[i]; }
                        pw[2 * nt] = pk2(pv[0], pv[1]); pw[2 * nt + 1] = pk2(pv[2], pv[3]); }
                    lrun[rt] += ps;
                    pf[rt][0] = __builtin_bit_cast(bf16x8, (u32x4){pw[0], pw[1], pw[2], pw[3]}); pf[rt][1] = __builtin_bit_cast(bf16x8, (u32x4){pw[4], pw[5], pw[6], pw[7]});
                }
#pragma unroll
                for (int nv = 0; nv < 8; ++nv)
#pragma unroll
                    for (int s2 = 0; s2 < 2; ++s2) { const LAS bf16_t* vp = VL + (nv * 16 + lr) * XA_VLD + kc * 64 + s2 * 32 + 4 * g;
                        const u32x2 lo = *(const LAS u32x2*)vp, hi = *(const LAS u32x2*)(vp + 16);
                        const bf16x8 vf = __builtin_bit_cast(bf16x8, (u32x4){lo.x, lo.y, hi.x, hi.y});
                        oacc[0][nv] = mfma16(vf, pf[0][s2], oacc[0][nv]); oacc[1][nv] = mfma16(vf, pf[1][s2], oacc[1][nv]); }
            }
#pragma unroll
            for (int rt = 0; rt < 2; ++rt) { float l = xr32_sum(xr16_sum(lrun[rt])); const float inv = frcp(l);
                bf16_t* orow = AO + (mbase + rt * 16 + lr) * 512 + h * 128 + 4 * g;
#pragma unroll
                for (int nv = 0; nv < 8; ++nv) { u32x2 o; o.x = pk2(oacc[rt][nv][0] * inv, oacc[rt][nv][1] * inv); o.y = pk2(oacc[rt][nv][2] * inv, oacc[rt][nv][3] * inv); *(u32x2*)(orow + nv * 16) = o; } }
        }
        LSYNC();
    }
}

#define GEMM_CALL(EPI, Aptr, Bptr, Mv, Nv, Kv, Optr, ldcv, rsv) do { pg8::Gemm gg_{(const bf16_t*)(Aptr), (const bf16_t*)(Bptr), (Mv), (Nv), (Kv)}; pg8::StaticOrder so_; so_.init((Mv), (Nv), C.G, C.bid); \
    pg8::EPI ee_{(bf16_t*)(Optr), (ldcv), (const float*)(rsv)}; pg8::gemm_phase<pg8::EPI>(C.lds, gg_, so_, ee_, C.tid); } while (0)

#define FUSED_CALL(Aptr, Bptr, Kv, EPOCH, SCALE, Gptr, OUTF) do { pg8::Gemm gg_{(const bf16_t*)(Aptr), (const bf16_t*)(Bptr), M, D, (Kv)}; pg8::StaticOrder so_; so_.init(M, D, C.G, C.bid); so_.imax = 1; \
    pg8::EpiFused ee_{XN_, (Gptr), (SCALE), WSP(float, WS_RSTD), (OUTF), WSP(float, WS_X1), WSP(float, WS_X2), (unsigned*)(C.ws + WS_CTL + 16384), 16u * ((unsigned)(EPOCH) + 1u), (unsigned*)(C.ws + WS_CTL + 15360)}; \
    const int ncall_ = (so_.nwg + C.G - 1) / C.G; _Pragma("unroll 1") for (int cc_ = 0; cc_ < ncall_; ++cc_) { so_.i0 = cc_; pg8::gemm_phase<pg8::EpiFused>(C.lds, gg_, so_, ee_, C.tid); LSYNC(); } } while (0)

__global__ void __launch_bounds__(NTHREADS, 2) fwd(Args a) {
    DYN_LDS(lds);
#define MKCTX() Ctx C; { int t_ = threadIdx.x; LAUNDER_V(t_); unsigned long long wi_ = (unsigned long long)a.ws, xi_ = (unsigned long long)a.out; LAUNDER_S(wi_); LAUNDER_S(xi_); unsigned char* w_ = (unsigned char*)(GAS unsigned char*)wi_; float* x_ = (float*)(GAS float*)xi_; int g_ = gridDim.x, b_ = blockIdx.x; LAUNDER_S(g_); LAUNDER_S(b_); LAS unsigned char* l_ = lds; LAUNDER_S(l_); \
    C.lds = l_; C.in.lds = l_; C.X = x_; C.ws = w_; C.tid = t_; C.lane = t_ & 63; C.wave = rfl(t_ >> 6); C.G = g_; C.bid = b_; }
    const int tid0 = threadIdx.x;
    volatile LAS unsigned* misc = (volatile LAS unsigned*)(lds + LDS_MISC);
    if (tid0 < 64) misc[tid0] = 0u;
    if (tid0 < N_IN) { const unsigned long long pv = (unsigned long long)a.in[tid0]; LAS unsigned* t = (LAS unsigned*)(lds + LDS_TAB); t[2 * tid0] = (unsigned)pv; t[2 * tid0 + 1] = (unsigned)(pv >> 32); }
    SYNC();
    XcdBarrier bar = xcd_barrier_post((unsigned*)(a.ws + WS_CTL), misc + 8);
    const int lo = a.ph_lo, hi = a.ph_hi;
    for (int j = 0; j < 2 * DEPTH; ++j) {
        const int l = j >> 1, s = j & 1, base = l * SLOTS, li = l >> 1; const bool even = !(l & 1);
#ifndef PHMASK
#define PHMASK 0x3ffff
#endif
#define IN(sl) (((PHMASK >> ((sl) > 14 ? (sl) - 14 : (sl))) & 1) && lo <= base + (sl) && base + (sl) < hi)
#define SEAM(sl) do { if (base + (sl) + 1 < hi) { XcdBarrier b2_ = bar; b2_.bar = (unsigned*)(C.ws + WS_CTL); LAUNDER_S(b2_.x); xcd_barrier(b2_, C.tid); } } while (0)
#define XN_ WSP(bf16_t, WS_XN)
#define HO_ ((bf16_t*)C.X)
#define BIG_ WSP(bf16_t, WS_BIG)
#define NG_ (C.in[I_NORMG] + (size_t)l * 8 * D)
        if (s == 0 && IN(0)) { MKCTX(); RPT(0) conv_phase(C, l, ((l & 1) && C.G > NB * 12) ? 2 : 3, C.bid, C.G); SEAM(0); }
        const int f0 = s ? 15 : 1;
        if (IN(f0)) { MKCTX(); RPT(1) GEMM_CALL(EpiSwiGLU, XN_, WSP(bf16_t, WS_WGU) + (size_t)s * NGU * D, M, NGU, D, BIG_, DFF, nullptr); SEAM(f0); }
        if (IN(f0 + 1)) { MKCTX(); const bool last = (s == 1 && l == DEPTH - 1); const float* ng = NG_;
            FUSED_CALL(BIG_, WSP(bf16_t, WS_WDN) + (size_t)s * D * DFF, DFF, l * 4 + (s ? 3 : 0), 0.5f, ng + (s ? 7 : 1) * D, last ? C.X : (float*)nullptr); SEAM(f0 + 1); }
        if (s == 0) {
            if (IN(4)) { MKCTX(); RPT(4) GEMM_CALL(EpiBf16, XN_, WSP(bf16_t, WS_WIN), M, even ? EV_IN : OD_INP, D, BIG_, even ? EV_IN : OD_INP, nullptr); SEAM(4); }
            if (IN(5)) {
                if (even) { const int NRW = NB * 8, NU = NRW + NB * 4;
                    { MKCTX(); RPT(5) for (int u = C.bid; u < NRW; u += C.G) { rwkv_unit2(C, u, li); SYNC(); } }
                    { MKCTX(); RPT(55) for (int u = C.bid + ((NRW + C.G - 1 - C.bid) / C.G) * C.G; u < NU; u += C.G) { ret_unit(C, u - NRW, li); SYNC(); } }
                    { MKCTX(); if (l + 1 < DEPTH && C.G > NU && C.bid >= NU) conv_phase(C, l + 1, 1, C.bid - NU, C.G - NU); } }
                else { MKCTX(); RPT(56) dsa_prep_phase(C, li); }
                { MKCTX(); SEAM(5); } }
            if (!even && IN(6)) { MKCTX(); RPT(6) GEMM_CALL(EpiBf16, WSP(bf16_t, WS_CQN), WSP(bf16_t, WS_WDQ), M, DQN, 256, BIG_ + (size_t)M * OD_INP, DQN, nullptr); SEAM(6); }
            if (!even && IN(7)) { MKCTX(); RPT(7) dsa_select_phase(C); SEAM(7); }
            if (!even && IN(8)) { MKCTX(); RPT(8) dsa_attn_phase(C); SEAM(8); }
            if (IN(9)) { MKCTX(); const float* ng = NG_; FUSED_CALL(WSP(bf16_t, WS_Y), WSP(bf16_t, WS_WOUT), even ? D : OD_Y, l * 4 + 1, 1.f, ng + 3 * D, (float*)nullptr); SEAM(9); }
            if (IN(11)) { MKCTX(); RPT(11)
#pragma unroll 1
                for (int k = 0; k < (l == 0 ? 3 : 1); ++k) {
                    const bf16_t* A_ = k == 0 ? XN_ : (k == 1 ? WSP(bf16_t, WS_MEMN) : DOP(DO_WV));
                    const bf16_t* B_ = k == 0 ? WSP(bf16_t, WS_WQ) : (k == 1 ? DOP(DO_WK) : WSP(bf16_t, WS_MEMN));
                    bf16_t* O_ = k == 0 ? BIG_ : (k == 1 ? DOP(DO_KB) : DOP(DO_VT));
                    const int M_ = k == 0 ? M : (k == 1 ? MM : DEPTH * 512), N_ = k == 0 ? 512 : (k == 1 ? DEPTH * 512 : MM);
                    GEMM_CALL(EpiBf16, A_, B_, M_, N_, D, O_, N_, nullptr); }
                SEAM(11); }
            if (IN(12)) { MKCTX(); RPT(12) xattn_phase(C, l); SEAM(12); }
            if (IN(13)) { MKCTX(); const float* ng = NG_; FUSED_CALL(BIG_ + (size_t)M * 512, WSP(bf16_t, WS_WO), 512, l * 4 + 2, 1.f, ng + 5 * D, (float*)nullptr); SEAM(13); }
        }
#undef IN
#undef SEAM
    }
}

static bool slot_used(int ph) { const int l = ph / SLOTS, sl = ph % SLOTS; if ((sl == 6 || sl == 7 || sl == 8) && !(l & 1)) return false; if (sl == 3 || sl == 10 || sl == 14 || sl == 17) return false;     return true; }
extern "C" void kernel_launch(void* const* d_in, const int* in_sizes, int n_in, void* d_out, int out_size, void* d_ws, size_t ws_size, hipStream_t stream) {
    (void)in_sizes; (void)out_size;
    if (n_in != N_IN || ws_size < WS_END) { fprintf(stderr, "kernel_launch: unexpected n_in %d or ws %zu < %zu\n", n_in, ws_size, (size_t)WS_END); return; }
    Args a; memset(&a, 0, sizeof(a));
    for (int i = 0; i < N_IN; ++i) a.in[i] = (const float*)d_in[i];
    a.out = (float*)d_out; a.ws = (unsigned char*)d_ws;
#ifdef EMU
    const int grid = emu_grid();
    memset((char*)d_ws + WS_CTL, 0, CTL_BYTES);
    if (emu_one_launch()) { a.ph_lo = emu_ph_lo(); a.ph_hi = emu_ph_hi(); emu_launch([=]() { fwd(a); }, grid, NTHREADS, LDS_BYTES, true); }
    else for (int ph = emu_ph_lo(); ph < emu_ph_hi(); ++ph) { if (!slot_used(ph)) continue; a.ph_lo = ph; a.ph_hi = ph + 1; fprintf(stderr, "[emu] phase %d (layer %d slot %d)\n", ph, ph / SLOTS, ph % SLOTS); emu_launch([=]() { fwd(a); }, grid, NTHREADS, LDS_BYTES, getenv("EMU_SERIAL") != nullptr); }
#else
    static int grid = 0;
    if (grid == 0) {
        int dev = 0, cus = 0;
        if (hipGetDevice(&dev) != hipSuccess || hipDeviceGetAttribute(&cus, hipDeviceAttributeMultiprocessorCount, dev) != hipSuccess) { grid = -1; return; }
        if (hipFuncSetAttribute((const void*)fwd, hipFuncAttributeMaxDynamicSharedMemorySize, LDS_BYTES) != hipSuccess) { fprintf(stderr, "kernel_launch: hipFuncSetAttribute failed\n"); grid = -1; return; }
        int per_cu = 0; (void)hipOccupancyMaxActiveBlocksPerMultiprocessor(&per_cu, (const void*)fwd, NTHREADS, LDS_BYTES); (void)hipGetLastError();
        grid = cus;
    }
    if (grid < 0) return;
    (void)hipMemsetAsync((char*)d_ws + WS_CTL, 0, CTL_BYTES, stream);
    if (MK_N_LAUNCHES == 1) { a.ph_lo = 0; a.ph_hi = NPH; hipLaunchKernelGGL(fwd, dim3(grid), dim3(NTHREADS), LDS_BYTES, stream, a); }
    else for (int ph = 0; ph < NPH; ++ph) { if (!slot_used(ph)) continue; a.ph_lo = ph; a.ph_hi = ph + 1; hipLaunchKernelGGL(fwd, dim3(grid), dim3(NTHREADS), LDS_BYTES, stream, a); }
#endif
}
```

```cpp
#ifndef EMU
#include <hip/hip_runtime.h>
#endif
#include <cstdio>
#include <cstdint>
#include <cstring>

#ifndef CFG_B
#define CFG_B 16
#endif
#ifndef CFG_S
#define CFG_S 2048
#endif
#ifndef CFG_DEPTH
#define CFG_DEPTH 4
#endif
#ifndef PROBE_SLOT
#define PROBE_SLOT -1
#define PROBE_N 1
#endif
#define RPT(sl) _Pragma("unroll 1") for (int rep_ = 0; rep_ < ((sl) == PROBE_SLOT ? PROBE_N : 1); ++rep_)
#ifndef MK_N_LAUNCHES
#define MK_N_LAUNCHES 1
#endif

typedef unsigned short bf16_t;
typedef short bf16x8 __attribute__((ext_vector_type(8)));
typedef float f32x4 __attribute__((ext_vector_type(4)));
typedef float f32x2 __attribute__((ext_vector_type(2)));
typedef unsigned u32x4 __attribute__((ext_vector_type(4)));
typedef unsigned u32x2 __attribute__((ext_vector_type(2)));

#ifdef EMU
#define LAS
#define GAS
#define WAIT_VM(n) do { } while (0)
#define WAIT_LGKM(n) emu_wave_sync()
#define WAIT_ALL() do { } while (0)
#define S_BARRIER() emu_barrier()
#define SYNC() emu_barrier()
#define LSYNC() emu_barrier()
#define SCHED_FENCE() do { } while (0)
#define SETPRIO(n) do { } while (0)
#define COMPILER_FENCE() do { } while (0)
static inline int rfl(int v) { return v; }
static inline f32x4 mfma16(bf16x8 a, bf16x8 b, f32x4 c) {
    struct AB { bf16x8 a, b; } mine{a, b};
    auto s = emu_xchg(&mine, sizeof(mine));
    const int lane = emu_cur()->tid & 63, col = lane & 15; f32x4 r = c;
    for (int i = 0; i < 4; ++i) { const int row = (lane >> 4) * 4 + i; float acc = 0.f;
        for (int g = 0; g < 4; ++g) { const AB* pa = (const AB*)s[row + 16 * g]; const AB* pb = (const AB*)s[col + 16 * g];
            for (int j = 0; j < 8; ++j) acc += emu_bf2f((unsigned short)pa->a[j]) * emu_bf2f((unsigned short)pb->b[j]); }
        r[i] += acc; }
    emu_wave_sync(); return r;
}
static inline void glds16(const void* g, unsigned char* lbase) { memcpy(lbase + (emu_cur()->tid & 63) * 16, g, 16); }
static inline unsigned long long ballot64(bool p) { return emu_ballot(p); }
static inline int popc64(unsigned long long v) { return __builtin_popcountll(v); }
static inline void setlane64(unsigned long long& w, unsigned long long bits, int i, int lane) { if (lane == i) w = bits; }
static inline unsigned atom_ld(unsigned* p) { return __atomic_load_n(p, __ATOMIC_SEQ_CST); }
static inline unsigned atom_add(unsigned* p, unsigned v) { return __atomic_fetch_add(p, v, __ATOMIC_SEQ_CST); }
static inline unsigned xcc_id() { return (unsigned)blockIdx.x & 7u; }
static inline void s_sleep1() { emu_spin_yield(); }
static inline void fence_release() { __atomic_thread_fence(__ATOMIC_SEQ_CST); }
static inline void fence_acquire() { __atomic_thread_fence(__ATOMIC_SEQ_CST); }
#define DYN_LDS(name) unsigned char* name = emu_lds()
#define LAUNDER_V(x) do { } while (0)
#define LAUNDER_S(x) do { } while (0)
#else
#define LAUNDER_V(x) asm volatile("" : "+v"(x))
#define LAUNDER_S(x) asm volatile("" : "+s"(x))
#define LAS __attribute__((address_space(3)))
#define GAS __attribute__((address_space(1)))
#define WAIT_VM(n) asm volatile("s_waitcnt vmcnt(" #n ")" ::: "memory")
#define WAIT_LGKM(n) asm volatile("s_waitcnt lgkmcnt(" #n ")" ::: "memory")
#define WAIT_ALL() asm volatile("s_waitcnt vmcnt(0) lgkmcnt(0)" ::: "memory")
#define S_BARRIER() __builtin_amdgcn_s_barrier()
#define SYNC() __syncthreads()
#define LSYNC() do { asm volatile("s_waitcnt lgkmcnt(0)" ::: "memory"); __builtin_amdgcn_s_barrier(); asm volatile("" ::: "memory"); } while (0)
#define SCHED_FENCE() __builtin_amdgcn_sched_barrier(0)
#define SETPRIO(n) __builtin_amdgcn_s_setprio(n)
#define COMPILER_FENCE() asm volatile("" ::: "memory")
__device__ __forceinline__ int rfl(int v) { return __builtin_amdgcn_readfirstlane(v); }
__device__ __forceinline__ f32x4 mfma16(bf16x8 a, bf16x8 b, f32x4 c) { return __builtin_amdgcn_mfma_f32_16x16x32_bf16(a, b, c, 0, 0, 0); }
__device__ __forceinline__ void glds16(const void* g, LAS unsigned char* lbase) { __builtin_amdgcn_global_load_lds((const unsigned*)g, (LAS unsigned*)lbase, 16, 0, 0); }
__device__ __forceinline__ unsigned long long ballot64(bool p) { return __ballot(p); }
__device__ __forceinline__ int popc64(unsigned long long v) { return __builtin_popcountll(v); }
__device__ __forceinline__ void setlane64(unsigned long long& w, unsigned long long bits, int i, int) {
    unsigned lo = (unsigned)w, hi = (unsigned)(w >> 32);
    asm("s_nop 1\n\tv_writelane_b32 %0, %2, %4\n\tv_writelane_b32 %1, %3, %4" : "+v"(lo), "+v"(hi) : "s"((unsigned)bits), "s"((unsigned)(bits >> 32)), "i"(i));
    w = ((unsigned long long)hi << 32) | lo; }
__device__ __forceinline__ unsigned atom_ld(unsigned* p) { return __hip_atomic_load(p, __ATOMIC_RELAXED, __HIP_MEMORY_SCOPE_AGENT); }
__device__ __forceinline__ unsigned atom_add(unsigned* p, unsigned v) { return __hip_atomic_fetch_add(p, v, __ATOMIC_RELAXED, __HIP_MEMORY_SCOPE_AGENT); }
__device__ __forceinline__ unsigned xcc_id() { return (unsigned)__builtin_amdgcn_s_getreg((3 << 11) | 20) & 0xFu; }
__device__ __forceinline__ void s_sleep1() { __builtin_amdgcn_s_sleep(1); }
__device__ __forceinline__ void fence_release() { __builtin_amdgcn_fence(__ATOMIC_RELEASE, "agent"); }
__device__ __forceinline__ void fence_acquire() { __builtin_amdgcn_fence(__ATOMIC_ACQUIRE, "agent"); }
#define DYN_LDS(name) extern __shared__ __attribute__((aligned(16))) unsigned char name##_raw[]; LAS unsigned char* name = (LAS unsigned char*)name##_raw
#endif

#ifdef EMU
__host__ __device__ __forceinline__ unsigned f2bf(float f) { unsigned u; memcpy(&u, &f, 4); return (u + 0x7fffu + ((u >> 16) & 1u)) >> 16; }
__host__ __device__ __forceinline__ unsigned pk2(float lo, float hi) { return f2bf(lo) | (f2bf(hi) << 16); }
static inline float frsq(float x) { return 1.f / sqrtf(x); }
#else
typedef __bf16 bf16x2_t __attribute__((ext_vector_type(2)));
__device__ __forceinline__ unsigned pk2(float lo, float hi) { const f32x2 v = {lo, hi}; return __builtin_bit_cast(unsigned, __builtin_convertvector(v, bf16x2_t)); }
__device__ __forceinline__ unsigned f2bf(float f) { return pk2(f, 0.f) & 0xffffu; }
__device__ __forceinline__ float frsq(float x) { return __builtin_amdgcn_rsqf(x); }
#endif
__host__ __device__ __forceinline__ float bf2f(unsigned b) { unsigned u = b << 16; float f; memcpy(&f, &u, 4); return f; }
__device__ __forceinline__ float bflo(unsigned w) { return bf2f(w & 0xffffu); }
__device__ __forceinline__ float bfhi(unsigned w) { return bf2f(w >> 16); }
#ifdef EMU
template <class T> static inline T shfl_xor_(T v, int m) { return __shfl_xor(v, m); }
template <class T> static inline T shfl_(T v, int l) { return __shfl(v, l); }
#else
__device__ __forceinline__ int lane_now() { int l = __builtin_amdgcn_mbcnt_hi(-1, __builtin_amdgcn_mbcnt_lo(-1, 0)); asm volatile("" : "+v"(l)); return l; }
__device__ __forceinline__ float shfl_xor_(float v, int m) { return __builtin_bit_cast(float, __builtin_amdgcn_ds_bpermute((lane_now() ^ m) << 2, __builtin_bit_cast(int, v))); }
__device__ __forceinline__ float shfl_(float v, int l) { return __builtin_bit_cast(float, __builtin_amdgcn_ds_bpermute(l << 2, __builtin_bit_cast(int, v))); }
#endif
#ifdef EMU
static inline void xr16_pair(float v, float& a, float& b) { const float o = shfl_xor_(v, 16); const int l = emu_cur()->tid & 63; if (l & 16) { a = o; b = v; } else { a = v; b = o; } }
static inline void xr32_pair(float v, float& a, float& b) { const float o = shfl_xor_(v, 32); const int l = emu_cur()->tid & 63; if (l & 32) { a = o; b = v; } else { a = v; b = o; } }
#else
__device__ __forceinline__ void xr16_pair(float v, float& a, float& b) { a = v; b = v; asm("s_nop 1\n\tv_permlane16_swap_b32 %0, %1" : "+v"(a), "+v"(b)); }
__device__ __forceinline__ void xr32_pair(float v, float& a, float& b) { a = v; b = v; asm("s_nop 1\n\tv_permlane32_swap_b32 %0, %1" : "+v"(a), "+v"(b)); }
#endif
#ifdef EMU
static inline void xr16_swap2(float& v0, float& v1) { const float p0 = shfl_xor_(v0, 16), p1 = shfl_xor_(v1, 16); const int l = emu_cur()->tid & 63; if (l & 16) v0 = p1; else v1 = p0; }
#else
__device__ __forceinline__ void xr16_swap2(float& v0, float& v1) { asm("s_nop 1\n\tv_permlane16_swap_b32 %0, %1" : "+v"(v0), "+v"(v1)); }
#endif
__device__ __forceinline__ float xr16_sum(float v) { float a, b; xr16_pair(v, a, b); return a + b; }
__device__ __forceinline__ float xr32_sum(float v) { float a, b; xr32_pair(v, a, b); return a + b; }
__device__ __forceinline__ float xr16_max(float v) { float a, b; xr16_pair(v, a, b); return fmaxf(a, b); }
__device__ __forceinline__ float xr32_max(float v) { float a, b; xr32_pair(v, a, b); return fmaxf(a, b); }
__device__ __forceinline__ float sum16d(float v);
__device__ __forceinline__ float wave_sum(float v) { return xr32_sum(xr16_sum(sum16d(v))); }
__device__ __forceinline__ float sum16(float v) { v += shfl_xor_(v, 1); v += shfl_xor_(v, 2); v += shfl_xor_(v, 4); v += shfl_xor_(v, 8); return v; }
__device__ __forceinline__ float max16(float v) { v = fmaxf(v, shfl_xor_(v, 1)); v = fmaxf(v, shfl_xor_(v, 2)); v = fmaxf(v, shfl_xor_(v, 4)); v = fmaxf(v, shfl_xor_(v, 8)); return v; }
__device__ __forceinline__ float sum8(float v) { v += shfl_xor_(v, 1); v += shfl_xor_(v, 2); v += shfl_xor_(v, 4); return v; }
#ifdef EMU
static inline float fexp2(float x) { return exp2f(x); }
static inline int bfe_i1(unsigned v, int pos) { return -(int)((v >> pos) & 1u); }
#else
__device__ __forceinline__ float fexp2(float x) { return __builtin_amdgcn_exp2f(x); }
__device__ __forceinline__ int bfe_i1(unsigned v, int pos) { int r; asm("v_bfe_i32 %0, %1, %2, 1" : "=v"(r) : "v"(v), "s"(pos)); return r; }
#endif
#ifdef EMU
static inline float frcp(float x) { return 1.f / x; }
#else
__device__ __forceinline__ float frcp(float x) { return __builtin_amdgcn_rcpf(x); }
#endif
__device__ __forceinline__ float sigmoidf_(float x) { return frcp(1.f + __expf(-x)); }
#ifdef EMU
template <int CTRL> static inline float dppf(float x) { const int l = emu_cur()->tid & 63;
    const int src = CTRL == 0xB1 ? (l ^ 1) : CTRL == 0x4E ? (l ^ 2) : CTRL == 0x141 ? ((l & ~7) | (7 - (l & 7))) : ((l & ~15) | (15 - (l & 15))); return emu_shfl(x, src); }
#else
template <int CTRL> __device__ __forceinline__ float dppf(float x) { return __builtin_bit_cast(float, __builtin_amdgcn_mov_dpp(__builtin_bit_cast(int, x), CTRL, 0xf, 0xf, true)); }
#endif
#ifdef EMU
template <int CTRL> static inline int dppi(int x) { return __builtin_bit_cast(int, dppf<CTRL>(__builtin_bit_cast(float, x))); }
static inline int readlane_i(int x, int l) { return emu_shfl(x, l); }
#else
template <int CTRL> __device__ __forceinline__ int dppi(int x) { return __builtin_amdgcn_mov_dpp(x, CTRL, 0xf, 0xf, true); }
__device__ __forceinline__ int readlane_i(int x, int l) { return __builtin_amdgcn_readlane(x, l); }
#endif
__device__ __forceinline__ float readlane_f(float x, int l) { return __builtin_bit_cast(float, readlane_i(__builtin_bit_cast(int, x), l)); }
__device__ __forceinline__ int wave_isum(int v) { v += dppi<0xB1>(v); v += dppi<0x4E>(v); v += dppi<0x141>(v); v += dppi<0x140>(v);
    return (readlane_i(v, 0) + readlane_i(v, 16)) + (readlane_i(v, 32) + readlane_i(v, 48)); }
__device__ __forceinline__ float sum8d(float v) { v += dppf<0xB1>(v); v += dppf<0x4E>(v); v += dppf<0x141>(v); return v; }
__device__ __forceinline__ float sum16d(float v) { v = sum8d(v); v += dppf<0x140>(v); return v; }
__device__ __forceinline__ float max16d(float v) { v = fmaxf(v, dppf<0xB1>(v)); v = fmaxf(v, dppf<0x4E>(v)); v = fmaxf(v, dppf<0x141>(v)); v = fmaxf(v, dppf<0x140>(v)); return v; }

constexpr int NB = CFG_B, SEQ = CFG_S, DEPTH = CFG_DEPTH, D = 1024, M = NB * SEQ, MEML = 256, MM = NB * MEML, DFF = 2816, NGU = 2 * DFF;
constexpr int TOPK = (256 < SEQ / 4) ? 256 : SEQ / 4;
constexpr int EV_IN = 3840, RW_IN = 1792, OD_INP = 2048  , OD_Y = 1536, DQN = 1536;
constexpr float EPS = 1e-6f, RW_LN_EPS = 64e-5f;
constexpr int NTHREADS = 512, NWAVES = 8;
constexpr int LDS_BYTES = 147456;
constexpr int LDS_MISC = 131072 + 12288, LDS_TAB = LDS_MISC + 256;
constexpr int SLOTS = 18;
constexpr int NPH = DEPTH * SLOTS;

constexpr size_t MiB = 1u << 20;
constexpr size_t al256(size_t x) { return (x + 255) & ~(size_t)255; }
constexpr size_t WS_CTL = 0, CTL_BYTES = 96 * 1024;
constexpr size_t WS_ROPE = WS_CTL + CTL_BYTES;
constexpr size_t WS_WGU = al256(WS_ROPE + (size_t)SEQ * 64 * 2 * 4);
constexpr size_t WS_WDN = WS_WGU + (size_t)2 * NGU * D * 2;
constexpr size_t WS_WQ = WS_WDN + (size_t)2 * D * DFF * 2;
constexpr size_t WS_WK = WS_WQ + (size_t)512 * D * 2;
constexpr size_t WS_WV = WS_WK + (size_t)512 * D * 2;
constexpr size_t WS_WO = WS_WV + (size_t)512 * D * 2;
constexpr size_t WS_WIN = WS_WO + (size_t)D * 512 * 2;
constexpr size_t WS_WOUT = WS_WIN + (size_t)EV_IN * D * 2;
constexpr size_t WS_WDQ = WS_WOUT + (size_t)D * OD_Y * 2;
constexpr size_t WS_W2T = WS_WDQ + (size_t)DQN * 256 * 2;
constexpr size_t WS_A2T = WS_W2T + (size_t)512 * 64 * 2;
constexpr size_t WS_G2T = WS_A2T + (size_t)512 * 64 * 2;
constexpr size_t WS_MEMN = al256(WS_G2T + (size_t)512 * 128 * 2);
constexpr size_t WS_KB = WS_MEMN + (size_t)MM * D * 2;
constexpr size_t WS_VT = WS_KB + (size_t)MM * 512 * 2;
constexpr size_t WS_XN = al256(WS_VT + (size_t)512 * MM * 2);
constexpr size_t WS_Y = WS_XN + (size_t)M * D * 2;
constexpr size_t WS_CQN = WS_Y + (size_t)M * OD_Y * 2;
constexpr size_t WS_CKV = WS_CQN + (size_t)M * 256 * 2;
constexpr size_t WS_CKVT = WS_CKV + (size_t)M * 128 * 2;
constexpr size_t WS_WI = WS_CKVT + (size_t)M * 128 * 2;
constexpr size_t WS_RSTD = al256(WS_WI + (size_t)M * 8 * 4);
constexpr size_t WS_KI = al256(WS_RSTD + (size_t)M * 4);
constexpr size_t WS_MASK = al256(WS_KI + (size_t)M * 64 * 2);
constexpr size_t WS_BIG = al256(WS_MASK + (size_t)M * (SEQ / 64) * 8);
constexpr size_t BIG_BYTES = (size_t)M * EV_IN * 2;
constexpr size_t WS_X1 = al256(WS_BIG + BIG_BYTES), WS_X2 = WS_X1 + (size_t)M * 4 * 4;
constexpr size_t WS_END = WS_X2 + (size_t)M * 4 * 4;
static_assert((size_t)M * (OD_INP + DQN) * 2 <= BIG_BYTES && (size_t)M * DFF * 2 <= BIG_BYTES, "BIG region");
static_assert(CFG_B != 16 || CFG_S != 2048 || WS_END <= (size_t)512 * MiB, "workspace must fit 512 MiB");

constexpr size_t DO_UP = (size_t)M * D * 2;
constexpr size_t DO_WK = DO_UP, DO_WV = DO_WK + (size_t)DEPTH * 512 * D * 2, DO_KB = DO_WV + (size_t)DEPTH * 512 * D * 2, DO_VT = DO_KB + (size_t)MM * DEPTH * 512 * 2, DO_END = DO_VT + (size_t)MM * DEPTH * 512 * 2;
static_assert(CFG_B != 16 || CFG_S != 2048 || DO_END <= (size_t)M * D * 4, "upper half of d_out");
#define DOP(off) ((bf16_t*)((unsigned char*)C.X + (off)))

#define XB_TMO      128
#define XB_XCNT(j)  (256  + 64 * (j))
#define XB_XSUB(j)  (1280 + 64 * (j))
#define XB_XGEN(j)  (2304 + 64 * (j))
#define XB_TOP      3328
#define XB_TOPGEN   3392
#define XCD_BAR_WORDS 3456
#define XB_SPIN_CAP (1u << 22)
#define XB_SPIN(cond, bar) do { unsigned _sp = 0; while (cond) { s_sleep1(); \
    if ((++_sp & 255u) == 0u) { if (atom_ld(&(bar)[XB_TMO])) break; if (_sp > XB_SPIN_CAP) { atom_add(&(bar)[XB_TMO], 1u); break; } } } } while (0)
struct XcdBarrier { unsigned* bar; unsigned x; volatile LAS unsigned* st; };
__device__ __forceinline__ XcdBarrier xcd_barrier_post(unsigned* bar, volatile LAS unsigned* st) {
    XcdBarrier b; b.bar = bar; b.x = xcc_id(); b.st = st;
    if (threadIdx.x == 0) (void)atom_add(&bar[XB_XCNT(b.x)], 1u);
    return b;
}
__device__ __forceinline__ void xcd_barrier_complete(unsigned* bar, unsigned x, unsigned& nloc, unsigned& nx) {
    const unsigned G = gridDim.x;
    unsigned sum, cnt, mine, sp = 0u;
    for (;;) {
        sum = 0u; cnt = 0u; mine = 0u;
#pragma unroll
        for (unsigned j = 0; j < 16; ++j) { const unsigned c = atom_ld(&bar[XB_XCNT(j)]); sum += c; cnt += (c > 0u) ? 1u : 0u; mine = (j == x) ? c : mine; }
        if (sum == G) break;
        s_sleep1();
        if ((++sp & 255u) == 0u) { if (atom_ld(&bar[XB_TMO])) break; if (sp > XB_SPIN_CAP) { atom_add(&bar[XB_TMO], 1u); break; } }
    }
    nloc = mine > 0u ? mine : 1u; nx = cnt > 0u ? cnt : 1u;
}
__device__ __forceinline__ void xcd_barrier(const XcdBarrier& b, const int tid) {
    WAIT_VM(0);
    SYNC();
    if (tid == 0) {
        unsigned* bar = b.bar;
        WAIT_ALL();
        unsigned nloc = b.st[0], nx = b.st[1];
        if (nloc == 0u) { xcd_barrier_complete(bar, b.x, nloc, nx); b.st[0] = nloc; b.st[1] = nx; }
        const unsigned old = atom_add(&bar[XB_XSUB(b.x)], 1u);
        const unsigned gen = old / nloc;
        if (old + 1u == (gen + 1u) * nloc) {
            fence_release();
            WAIT_VM(0);
            const unsigned og = atom_add(&bar[XB_TOP], 1u);
            const unsigned tg = og / nx;
            if (og + 1u == (tg + 1u) * nx) atom_add(&bar[XB_TOPGEN], 1u);
            else XB_SPIN(atom_ld(&bar[XB_TOPGEN]) == tg, bar);
            fence_acquire();
            atom_add(&bar[XB_XGEN(b.x)], 1u);
            WAIT_VM(0);
        } else {
            XB_SPIN(atom_ld(&bar[XB_XGEN(b.x)]) == gen, bar);
            fence_acquire();
            WAIT_VM(0);
        }
    }
    SYNC();
}

namespace pg8 {
constexpr int BM = 256, BK = 64, HALF = 128, HTB = HALF * BK * 2, STAGE_BYTES = 8 * HTB, NXCD = 8, WGM = 8;
__host__ __device__ __forceinline__ int lds_byte(int r, int c) { const int st = (r >> 4) * 2 + (c >> 5), rr = r & 15, cc = c & 31, ob = rr * 64 + cc * 2; return st * 1024 + (ob ^ (((ob >> 9) & 1) << 5)); }
__host__ __device__ __forceinline__ void stage_rc(int b, int& R, int& C) { const int st = b / 1024, sb = b % 1024, swz = sb ^ (((sb >> 9) & 1) << 5); R = (st >> 1) * 16 + swz / 64; C = (st & 1) * 32 + (swz % 64) / 2; }
__host__ __device__ __forceinline__ int perm32(int rho) { const int n = rho >> 4, i = rho & 15; return 8 * (i >> 2) + 4 * n + (i & 3); }
struct Unit { int pm, pn; };
struct Gemm { const bf16_t* A; const bf16_t* Bt; int M, N, K; };
struct StaticOrder {
    int nM, nN, nwg, G, c, i0, imax;
    __host__ __device__ void init(int M_, int N_, int G_, int c_) { nM = M_ / BM; nN = N_ / BM; nwg = nM * nN; G = G_; c = c_; i0 = 0; imax = 1 << 30; }
    __host__ __device__ bool next(int i, Unit& u) const {
        if (i >= imax) return false;
        const long L = (long)(i + i0) * G + c; if (L >= nwg) return false;
        int wgid = (int)L; { const int q = nwg / NXCD, r = nwg % NXCD, xcd = wgid % NXCD, off = wgid / NXCD; wgid = (xcd < r ? xcd * (q + 1) : r * (q + 1) + (xcd - r) * q) + off; }
        const int nig = WGM * nN, gid = wgid / nig, fm = gid * WGM, gsz = (nM - fm) < WGM ? (nM - fm) : WGM;
        u.pm = fm + ((wgid % nig) % gsz); u.pn = (wgid % nig) / gsz; return true;
    }
};
struct EpiBf16 {
    static constexpr bool FUSED = false;
    bf16_t* O; int ldc; const float* rs;
    __device__ __forceinline__ void operator()(const f32x4 (&acc)[2][2][4][2], const Unit& u, int wr, int wc, int fr, int fq) const {
        const int row0 = u.pm * BM + wr * 64 + fr, col0 = u.pn * BM + wc * 32 + 8 * fq;
#pragma unroll
        for (int ai = 0; ai < 2; ++ai)
#pragma unroll
            for (int m = 0; m < 4; ++m) { const int row = row0 + ai * HALF + m * 16; bf16_t* rowp = O + (size_t)row * ldc + col0;
#pragma unroll
                for (int bj = 0; bj < 2; ++bj) { const f32x4 v0 = acc[ai][bj][m][0], v1 = acc[ai][bj][m][1];
                    u32x4 w; w.x = pk2(v0[0], v0[1]); w.y = pk2(v0[2], v0[3]); w.z = pk2(v1[0], v1[1]); w.w = pk2(v1[2], v1[3]);
                    *(u32x4*)(rowp + bj * HALF) = w; } }
    }
};
struct EpiSwiGLU {
    static constexpr bool FUSED = false;
    bf16_t* O; int ldc; const float* rs;
    __device__ __forceinline__ void operator()(const f32x4 (&acc)[2][2][4][2], const Unit& u, int wr, int wc, int fr, int fq) const {
        const int row0 = u.pm * BM + wr * 64 + fr, col0 = u.pn * HALF + wc * 32 + 8 * fq;
        f32x2 one2 = {1.f, 1.f}; LAUNDER_V(one2); const f32x4 one4 = {one2.x, one2.y, one2.x, one2.y};
#pragma unroll
        for (int ai = 0; ai < 2; ++ai)
#pragma unroll
            for (int m = 0; m < 4; ++m) { const int row = row0 + ai * HALF + m * 16; bf16_t* rowp = O + (size_t)row * ldc + col0;
                float o[8];
#pragma unroll
                for (int n = 0; n < 2; ++n) { const f32x4 g4 = acc[ai][0][m][n], u4 = acc[ai][1][m][n]; f32x4 e4 = g4 * -1.4426950408889634f, r4;
#pragma unroll
                    for (int j = 0; j < 4; ++j) e4[j] = fexp2(e4[j]);
                    e4 = e4 + one4;
#pragma unroll
                    for (int j = 0; j < 4; ++j) r4[j] = frcp(e4[j]);
                    const f32x4 o4 = (g4 * u4) * r4;
#pragma unroll
                    for (int j = 0; j < 4; ++j) o[n * 4 + j] = o4[j]; }
                u32x4 w; w.x = pk2(o[0], o[1]); w.y = pk2(o[2], o[3]); w.z = pk2(o[4], o[5]); w.w = pk2(o[6], o[7]);
                *(u32x4*)rowp = w; }
    }
};

#ifdef EMU
#define FUSED_SPIN_CAP 0xfffffff0u
#else
#define FUSED_SPIN_CAP (1u << 22)
#endif
struct EpiFused {
    static constexpr bool FUSED = true;
    bf16_t* XB; const float* g; float scale; float* RS; float* outf; float* X1; float* X2; unsigned* cnt; unsigned want; unsigned* tmo;
    __device__ __forceinline__ void operator()(const f32x4 (&)[2][2][4][2], const Unit&, int, int, int, int) const {}
    __device__ __forceinline__ void exchange(LAS float* P, LAS float* S, float* X, unsigned* cw, const Unit& u, int tid, bool is_rstd_out) const {
        const int row = tid & 255;
        if (tid < 256) { const f32x4 p = *(const LAS f32x4*)(P + row * 4); const float part = (p[0] + p[1]) + (p[2] + p[3]);
#ifdef EMU
            X[((size_t)u.pm * 256 + row) * 4 + u.pn] = part;
#else
            __hip_atomic_store((unsigned*)(X + ((size_t)u.pm * 256 + row) * 4 + u.pn), __builtin_bit_cast(unsigned, part), __ATOMIC_RELAXED, __HIP_MEMORY_SCOPE_AGENT);
#endif
            WAIT_VM(0);
            if ((tid & 63) == 0) atom_add(cw, 1u); }
        if (tid < 64) { unsigned sp = 0;
            while ((unsigned)rfl((int)atom_ld(cw)) < want) { s_sleep1(); if ((++sp & 1023u) == 0u) { if (atom_ld(tmo)) break; if (sp > FUSED_SPIN_CAP) { atom_add(tmo, 1u); break; } } }
            fence_acquire(); WAIT_VM(0); }
        SYNC();
        if (tid < 256) {
#ifdef EMU
            const float* xp = X + ((size_t)u.pm * 256 + row) * 4; const float tot = (xp[0] + xp[1]) + (xp[2] + xp[3]);
#else
            const unsigned* xp = (const unsigned*)(X + ((size_t)u.pm * 256 + row) * 4); float tot = 0.f;
#pragma unroll
            for (int q = 0; q < 4; ++q) tot += __builtin_bit_cast(float, __hip_atomic_load(xp + q, __ATOMIC_RELAXED, __HIP_MEMORY_SCOPE_AGENT));
#endif
            const float r = frsq(tot * (1.f / 1024.f) + 1e-6f); S[row] = r;
            if (is_rstd_out && u.pn == 0) RS[(size_t)u.pm * 256 + row] = frcp(r); }
        SYNC();
    }
    __device__ __forceinline__ void fused(f32x4 (&acc)[2][2][4][2], const Unit& u, int wr, int wc, int fr_, int fq_, LAS unsigned char* lds, int tid_) const {
        int tid = tid_; LAUNDER_V(tid);
        const int fr = tid & 15, fq = (tid & 63) >> 4; (void)fr_; (void)fq_;
        LAS float* P = (LAS float*)lds; LAS float* S = P + 1024;
#pragma unroll
        for (int ai = 0; ai < 2; ++ai)
#pragma unroll
            for (int m = 0; m < 4; ++m) { float q = 0.f;
#pragma unroll
                for (int bj = 0; bj < 2; ++bj)
#pragma unroll
                    for (int n = 0; n < 2; ++n) { const f32x4 v = acc[ai][bj][m][n]; q += (v[0] * v[0] + v[1] * v[1]) + (v[2] * v[2] + v[3] * v[3]); }
                q = xr32_sum(xr16_sum(q)); if (fq == 0) P[(ai * HALF + wr * 64 + m * 16 + fr) * 4 + wc] = q; }
        const int col0 = u.pn * BM + wc * 32 + 8 * fq;
        u32x4 xwv[4][2]; float sov[2][4];
#pragma unroll
        for (int ai = 0; ai < 2; ++ai)
#pragma unroll
            for (int m = 0; m < 4; ++m) { const size_t row = (size_t)u.pm * BM + ai * HALF + wr * 64 + m * 16 + fr; sov[ai][m] = RS[row];
                if (ai == 0) {
#pragma unroll
                    for (int bj = 0; bj < 2; ++bj) xwv[m][bj] = *(const u32x4*)(XB + row * 1024 + col0 + bj * HALF); } }
        SYNC();
        exchange(P, S, X1, cnt + (size_t)u.pm * 64, u, tid, false);
        float gv[2][8];
#pragma unroll
        for (int bj = 0; bj < 2; ++bj) { const f32x4 a = *(const f32x4*)(g + col0 + bj * HALF), b2 = *(const f32x4*)(g + col0 + bj * HALF + 4);
#pragma unroll
            for (int k = 0; k < 4; ++k) { gv[bj][k] = a[k] * scale; gv[bj][4 + k] = b2[k] * scale; } }
#pragma unroll
        for (int ai = 0; ai < 2; ++ai)
#pragma unroll
            for (int m = 0; m < 4; ++m) { const int rl = ai * HALF + wr * 64 + m * 16 + fr; const size_t row = (size_t)u.pm * BM + rl; const float rh = S[rl], so = sov[ai][m]; float q = 0.f;
#pragma unroll
                for (int bj = 0; bj < 2; ++bj) { const u32x4 xw = (ai == 0) ? xwv[m][bj] : *(const u32x4*)(XB + row * 1024 + col0 + bj * HALF); float xv[8];
#pragma unroll
                    for (int k = 0; k < 4; ++k) { xv[2 * k] = bflo(xw[k]) * so; xv[2 * k + 1] = bfhi(xw[k]) * so; }
#pragma unroll
                    for (int n = 0; n < 2; ++n)
#pragma unroll
                        for (int j = 0; j < 4; ++j) { const float nv = xv[4 * n + j] + acc[ai][bj][m][n][j] * rh * gv[bj][4 * n + j]; acc[ai][bj][m][n][j] = nv; q += nv * nv; }
                    if (outf) { float* op = outf + row * 1024 + col0 + bj * HALF; *(f32x4*)op = acc[ai][bj][m][0]; *(f32x4*)(op + 4) = acc[ai][bj][m][1]; } }
                q = xr32_sum(xr16_sum(q)); if (fq == 0) P[rl * 4 + wc] = q; }
        if (outf) return;
        SYNC();
        exchange(P, S, X2, cnt + (size_t)(128 + u.pm) * 64, u, tid, true);
#pragma unroll
        for (int ai = 0; ai < 2; ++ai)
#pragma unroll
            for (int m = 0; m < 4; ++m) { const int rl = ai * HALF + wr * 64 + m * 16 + fr; const size_t row = (size_t)u.pm * BM + rl; const float rn = S[rl];
#pragma unroll
                for (int bj = 0; bj < 2; ++bj) { const f32x4 v0 = acc[ai][bj][m][0] * rn, v1 = acc[ai][bj][m][1] * rn;
                    u32x4 w; w.x = pk2(v0[0], v0[1]); w.y = pk2(v0[2], v0[3]); w.z = pk2(v1[0], v1[1]); w.w = pk2(v1[2], v1[3]); *(u32x4*)(XB + row * 1024 + col0 + bj * HALF) = w; } }
    }
};

template <class Epi>
__device__ __forceinline__ void gemm_phase(LAS unsigned char* lds, const Gemm g, const StaticOrder& S, const Epi& E, const int tid) {
    const int wid = rfl(tid >> 6), lane = tid & 63, wr = wid >> 2, wc = wid & 3, fr = lane & 15, fq = lane >> 4;
    const int K = g.K, nt = K / BK;
    unsigned voffA[2], voffB[2];
#pragma unroll
    for (int i = 0; i < 2; ++i) { int R, C; stage_rc(tid * 16 + i * 8192, R, C); const int Rb = (R & ~31) + perm32(R & 31);
        voffA[i] = (unsigned)(R * K + C) * 2u; voffB[i] = (unsigned)(Rb * K + C) * 2u; }
    const size_t kstep = (size_t)(BK * 2);
    const size_t hstep = (size_t)HALF * K * 2;
    const size_t tstep = 2 * hstep;
    const unsigned ldsw = (unsigned)wid * 1024u;
    const int aoff = lds_byte(wr * 64 + fr, fq * 8), boff = lds_byte(wc * 32 + fr, fq * 8);
#define PG8_SA(b, h) (((b) * 2 + (h)) * HTB)
#define PG8_SB(b, h) ((4 + (b) * 2 + (h)) * HTB)
#define PG8_STAGE(bufoff, gbase, voff) do { _Pragma("unroll") for (int _i = 0; _i < 2; ++_i) \
        glds16((const char*)(gbase) + (voff)[_i], lds + (bufoff) + ldsw + _i * 8192); } while (0)
#define PG8_LDA(dst, b, h) do { _Pragma("unroll") for (int m = 0; m < 4; ++m) _Pragma("unroll") for (int k = 0; k < 2; ++k) dst[m][k] = *(const LAS bf16x8*)(lds + PG8_SA(b, h) + aoff + m * 2048 + k * 1024); } while (0)
#define PG8_LDB(dst, b, h) do { _Pragma("unroll") for (int n = 0; n < 2; ++n) _Pragma("unroll") for (int k = 0; k < 2; ++k) dst[n][k] = *(const LAS bf16x8*)(lds + PG8_SB(b, h) + boff + n * 2048 + k * 1024); } while (0)
#define PG8_MMA(ai, bj, At, Bt) do { SETPRIO(1); _Pragma("unroll") for (int m = 0; m < 4; ++m) _Pragma("unroll") for (int n = 0; n < 2; ++n) _Pragma("unroll") for (int k = 0; k < 2; ++k) \
        acc[ai][bj][m][n] = mfma16(Bt[n][k], At[m][k], acc[ai][bj][m][n]); SETPRIO(0); } while (0)
#define PG8_BAR S_BARRIER()
#define PG8_SCHED SCHED_FENCE()
    Unit cur, nxt; int ui = 0;
    if (!S.next(0, cur)) return;
    f32x4 acc[2][2][4][2];
#pragma unroll
    for (int a = 0; a < 2; ++a)
#pragma unroll
        for (int b = 0; b < 2; ++b)
#pragma unroll
            for (int m = 0; m < 4; ++m)
#pragma unroll
                for (int n = 0; n < 2; ++n) acc[a][b][m][n] = (f32x4){0.f, 0.f, 0.f, 0.f};
    bf16x8 At[4][2], B0[2][2], B1[2][2];
    const char* cA = (const char*)g.A + (size_t)cur.pm * tstep; const char* cB = (const char*)g.Bt + (size_t)cur.pn * tstep;
    PG8_STAGE(PG8_SB(0, 0), cB, voffB); PG8_STAGE(PG8_SB(0, 1), cB + hstep, voffB); PG8_STAGE(PG8_SA(0, 0), cA, voffA); PG8_STAGE(PG8_SA(0, 1), cA + hstep, voffA);
    if (wr == 1) PG8_BAR;
    WAIT_VM(2); PG8_BAR;
    PG8_STAGE(PG8_SB(1, 0), cB + kstep, voffB); PG8_STAGE(PG8_SA(1, 0), cA + kstep, voffA); PG8_STAGE(PG8_SB(1, 1), cB + hstep + kstep, voffB);
    WAIT_VM(6); PG8_BAR;
    for (;;) {
        const bool has_next = S.next(ui + 1, nxt);
        const char* nA = has_next ? (const char*)g.A + (size_t)nxt.pm * tstep : cA; const char* nB = has_next ? (const char*)g.Bt + (size_t)nxt.pn * tstep : cB;
        for (int t = 0; t < nt; t += 2) {
            const bool last = (t == nt - 2);
            const char* a1 = cA + (size_t)(t + 1) * kstep;
            const char* a2 = last ? nA : cA + (size_t)(t + 2) * kstep; const char* b2 = last ? nB : cB + (size_t)(t + 2) * kstep;
            const char* a3 = a2 + kstep; const char* b3 = b2 + kstep;
            PG8_LDB(B0, 0, 0); PG8_LDB(B1, 0, 1); PG8_SCHED; PG8_LDA(At, 0, 0); PG8_STAGE(PG8_SA(1, 1), a1 + hstep, voffA);
            WAIT_VM(8); WAIT_LGKM(0); PG8_BAR; PG8_MMA(0, 0, At, B0); PG8_MMA(0, 1, At, B1); PG8_BAR; PG8_SCHED;
            PG8_LDA(At, 0, 1); PG8_STAGE(PG8_SB(0, 0), b2, voffB); PG8_STAGE(PG8_SB(0, 1), b2 + hstep, voffB); PG8_STAGE(PG8_SA(0, 0), a2, voffA);
            WAIT_VM(8); WAIT_LGKM(0); PG8_BAR; PG8_MMA(1, 0, At, B0); PG8_MMA(1, 1, At, B1); PG8_BAR; PG8_SCHED;
            PG8_LDB(B0, 1, 0); PG8_LDB(B1, 1, 1); PG8_SCHED; PG8_LDA(At, 1, 0); PG8_STAGE(PG8_SA(0, 1), a2 + hstep, voffA);
            WAIT_VM(8); WAIT_LGKM(0); PG8_BAR; PG8_MMA(0, 0, At, B0); PG8_MMA(0, 1, At, B1); PG8_BAR; PG8_SCHED;
            PG8_LDA(At, 1, 1); PG8_STAGE(PG8_SB(1, 0), b3, voffB); PG8_STAGE(PG8_SB(1, 1), b3 + hstep, voffB); PG8_STAGE(PG8_SA(1, 0), a3, voffA);
            WAIT_VM(8); WAIT_LGKM(0); PG8_BAR; PG8_MMA(1, 0, At, B0); PG8_MMA(1, 1, At, B1); PG8_BAR; PG8_SCHED;
        }
        if (wr == 0) PG8_BAR;
        if constexpr (!Epi::FUSED) E(acc, cur, wr, wc, fr, fq);
        if (!has_next) break;
#pragma unroll
        for (int a = 0; a < 2; ++a)
#pragma unroll
            for (int b = 0; b < 2; ++b)
#pragma unroll
                for (int m = 0; m < 4; ++m)
#pragma unroll
                    for (int n = 0; n < 2; ++n) acc[a][b][m][n] = (f32x4){0.f, 0.f, 0.f, 0.f};
        cur = nxt; cA = nA; cB = nB; ++ui;
        if (wr == 1) PG8_BAR;
    }
    WAIT_VM(0);
    PG8_BAR;
    if constexpr (Epi::FUSED) E.fused(acc, cur, wr, wc, fr, fq, lds, tid);
#undef PG8_SA
#undef PG8_SB
#undef PG8_STAGE
#undef PG8_LDA
#undef PG8_LDB
#undef PG8_MMA
#undef PG8_BAR
#undef PG8_SCHED
}
}

enum { I_X = 0, I_MEM, I_NORMG, I_MEMG, I_FGATE, I_FUP, I_FDOWN, I_XAQ, I_XAK, I_XAV, I_XAO, I_EVIN, I_EVOUT,
       I_RWMU, I_RWW0, I_RWW2, I_RWA0, I_RWA2, I_RWG2, I_RWKK, I_RWKA, I_RWRK, I_RWLNG, I_RWLNB, I_RTG, I_RTB,
       I_ODIN, I_ODOUT, I_DQG, I_DKVG, I_DUQ, I_DUK, I_DUV, I_DQI, I_SCW, I_SCB, N_IN };
struct Args { const float* in[N_IN]; float* out; unsigned char* ws; int ph_lo, ph_hi; };

struct InTab {
    LAS unsigned char* lds;
    __device__ __forceinline__ const float* operator[](int k) const { const LAS unsigned* t = (const LAS unsigned*)(lds + LDS_TAB);
        const unsigned lo = (unsigned)rfl((int)t[2 * k]), hi = (unsigned)rfl((int)t[2 * k + 1]); return (const float*)(const GAS float*)(((unsigned long long)hi << 32) | lo); }
};
struct Ctx {
    LAS unsigned char* lds; InTab in; float* X; unsigned char* ws;
    int tid, lane, wave, G, bid;
};
#define WSP(T, off) ((T*)(C.ws + (off)))

__device__ __forceinline__ void tconv(const Ctx& C, const float* W, int K, int N, int ldsrc, bf16_t* WT, int ldd, int grp, int gstride, int goff, int mode) {
    LAS float* scr = (LAS float*)(C.lds + C.wave * 8704);
    const int gw = C.bid * NWAVES + C.wave, NGW = C.G * NWAVES, lane = C.lane;
    const int nblk = (N + 31) / 32, nitems = (K / 64) * nblk;
    for (int item = gw; item < nitems; item += NGW) {
        const int kb = item / nblk, nb = item % nblk, k0 = 64 * kb, n0 = 32 * nb;
        const int nn = n0 + (lane & 31);
#pragma unroll 8
        for (int i = 0; i < 32; ++i) { const int kk = 2 * i + (lane >> 5); scr[kk * 33 + (lane & 31)] = (nn < N) ? W[(size_t)(k0 + kk) * ldsrc + nn] : 0.f; }
        WAIT_LGKM(0); COMPILER_FENCE();
        const int c = lane & 7;
#pragma unroll
        for (int j = 0; j < 4; ++j) { const int nl = (lane >> 3) + 8 * j, n = n0 + nl; const LAS float* s = scr + (8 * c) * 33 + nl;
            u32x4 o; o.x = pk2(s[0 * 33], s[1 * 33]); o.y = pk2(s[2 * 33], s[3 * 33]); o.z = pk2(s[4 * 33], s[5 * 33]); o.w = pk2(s[6 * 33], s[7 * 33]);
            if (n < N) { const int dr = (mode == 1) ? (n < 456 ? n : n + 56) : ((n / grp) * gstride + goff + (n % grp));
                *(u32x4*)(WT + (size_t)dr * ldd + k0 + 8 * c) = o; } }
        WAIT_LGKM(0); COMPILER_FENCE();
    }
}

__device__ __forceinline__ void tconv_tile(const Ctx& C, const float* W, int N, int ldsrc, bf16_t* WT, int ldd, int grp, int gstride, int goff, int mode, int tile, const float* rsc, float cmul = 1.f) {
    LAS float* scr = (LAS float*)C.lds; const int tid = C.tid;
    const int nblk = (N + 127) / 128, kb = tile / nblk, nb = tile % nblk, k0 = 256 * kb, n0 = 128 * nb;
    { const int r = tid >> 5, c4 = (tid & 31) * 4; const bool full = (n0 + c4 + 3 < N);
      f32x4 vv[16];
#pragma unroll
      for (int ps = 0; ps < 16; ++ps) { const int kk = ps * 16 + r; const float* src = W + (size_t)(k0 + kk) * ldsrc + n0 + c4; f32x4 v = {0.f, 0.f, 0.f, 0.f};
          if (full) v = *(const f32x4*)src; else { if (n0 + c4 < N) v[0] = src[0]; if (n0 + c4 + 1 < N) v[1] = src[1]; if (n0 + c4 + 2 < N) v[2] = src[2]; }
          vv[ps] = v; }
#pragma unroll
      for (int ps = 0; ps < 16; ++ps) { const int kk = ps * 16 + r; f32x4 v = vv[ps];
          if (rsc) v = v * (rsc[k0 + kk] * cmul);
          LAS float* d = scr + kk * 129 + c4; d[0] = v[0]; d[1] = v[1]; d[2] = v[2]; d[3] = v[3]; } }
    LSYNC();
    { const int nr = tid >> 5, ksg = tid & 31;
#pragma unroll 2
      for (int ps = 0; ps < 8; ++ps) { const int nl = ps * 16 + nr, n = n0 + nl; const LAS float* sp = scr + (8 * ksg) * 129 + nl;
          u32x4 o; o.x = pk2(sp[0], sp[129]); o.y = pk2(sp[2 * 129], sp[3 * 129]); o.z = pk2(sp[4 * 129], sp[5 * 129]); o.w = pk2(sp[6 * 129], sp[7 * 129]);
          if (n < N) { const int dr = (mode == 1) ? (n < 456 ? n : n + 56) : ((n / grp) * gstride + goff + (n % grp)); *(u32x4*)(WT + (size_t)dr * ldd + k0 + 8 * ksg) = o; } } }
    LSYNC();
}
constexpr int TH_R = 2;
__device__ __forceinline__ void thin_phase(const Ctx& C, const float* xin, const bf16_t* HO, float scale, const float* ga, float* outf) {
    const int gw = C.bid * NWAVES + C.wave, NGW = C.G * NWAVES, lane = C.lane; bf16_t* XB = WSP(bf16_t, WS_XN); float* RS = WSP(float, WS_RSTD);
    float gv[2][8];
    if (!xin) {
#pragma unroll
        for (int j = 0; j < 2; ++j) { const f32x4 a = *(const f32x4*)(ga + 8 * lane + 512 * j), b2 = *(const f32x4*)(ga + 8 * lane + 512 * j + 4);
#pragma unroll
            for (int k = 0; k < 4; ++k) { gv[j][k] = a[k]; gv[j][4 + k] = b2[k]; } } }
    for (int m0 = TH_R * gw; m0 < M; m0 += TH_R * NGW) {
        float v[TH_R][2][8];
        if (xin) {
#pragma unroll
            for (int r = 0; r < TH_R; ++r)
#pragma unroll
                for (int j = 0; j < 2; ++j) { const float* p_ = xin + (size_t)(m0 + r) * D + 8 * lane + 512 * j; const f32x4 a = *(const f32x4*)p_, b2 = *(const f32x4*)(p_ + 4);
#pragma unroll
                    for (int k = 0; k < 4; ++k) { v[r][j][k] = a[k]; v[r][j][4 + k] = b2[k]; } }
        } else {
            u32x4 xw[TH_R][2], hw[TH_R][2];
#pragma unroll
            for (int r = 0; r < TH_R; ++r)
#pragma unroll
                for (int j = 0; j < 2; ++j) { xw[r][j] = *(const u32x4*)(XB + (size_t)(m0 + r) * D + 8 * lane + 512 * j); hw[r][j] = *(const u32x4*)(HO + (size_t)(m0 + r) * D + 8 * lane + 512 * j); }
#pragma unroll
            for (int r = 0; r < TH_R; ++r) { float h[2][8]; float ss = 0.f;
#pragma unroll
                for (int j = 0; j < 2; ++j)
#pragma unroll
                    for (int k = 0; k < 4; ++k) { h[j][2 * k] = bflo(hw[r][j][k]); h[j][2 * k + 1] = bfhi(hw[r][j][k]); v[r][j][2 * k] = bflo(xw[r][j][k]); v[r][j][2 * k + 1] = bfhi(xw[r][j][k]);
                        ss += h[j][2 * k] * h[j][2 * k] + h[j][2 * k + 1] * h[j][2 * k + 1]; }
                const float rr = scale * frsq(wave_sum(ss) * (1.f / D) + EPS);
#pragma unroll
                for (int j = 0; j < 2; ++j)
#pragma unroll
                    for (int k = 0; k < 8; ++k) v[r][j][k] += h[j][k] * gv[j][k] * rr; }
        }
#pragma unroll
        for (int r = 0; r < TH_R; ++r) {
            if (outf) {
#pragma unroll
                for (int j = 0; j < 2; ++j) { float* p_ = outf + (size_t)(m0 + r) * D + 8 * lane + 512 * j;
                    *(f32x4*)p_ = (f32x4){v[r][j][0], v[r][j][1], v[r][j][2], v[r][j][3]}; *(f32x4*)(p_ + 4) = (f32x4){v[r][j][4], v[r][j][5], v[r][j][6], v[r][j][7]}; }
            } else { float ss = 0.f;
#pragma unroll
                for (int j = 0; j < 2; ++j)
#pragma unroll
                    for (int k = 0; k < 8; ++k) ss += v[r][j][k] * v[r][j][k];
                ss = wave_sum(ss); const float rstd = frsq(ss * (1.f / D) + EPS);
#pragma unroll
                for (int j = 0; j < 2; ++j) { u32x4 w;
#pragma unroll
                    for (int k = 0; k < 4; ++k) w[k] = pk2(v[r][j][2 * k] * rstd, v[r][j][2 * k + 1] * rstd);
                    *(u32x4*)(XB + (size_t)(m0 + r) * D + 8 * lane + 512 * j) = w; }
                if (lane == 0) RS[m0 + r] = frcp(rstd); }
        }
    }
}

__device__ __forceinline__ void conv_phase(const Ctx& C, int l, int parts, int vb, int vg) {
    const InTab in = C.in; const int li = l >> 1; const bool even = !(l & 1);
    const int gtid = C.bid * NTHREADS + C.tid, NT = C.G * NTHREADS;
    int gt = vb, toff = 0; const float* ngp = in[I_NORMG] + (size_t)l * 8 * D;
#define TCB(W_, K_, N_, LDS_, WT_, LDD_, GRP_, GST_, GOF_, MODE_, RSC_, ...) do { const int nt_ = ((K_) / 256) * (((N_) + 127) / 128); \
        while (gt < toff + nt_) { tconv_tile(C, (W_), (N_), (LDS_), (WT_), (LDD_), (GRP_), (GST_), (GOF_), (MODE_), gt - toff, (RSC_), ##__VA_ARGS__); gt += vg; } toff += nt_; } while (0)
#pragma unroll 1
    for (int s = 0; s < 2; ++s) if ((parts >> s) & 1) {
        const size_t wofs = ((size_t)l * 2 + s) * D * DFF;
        TCB(in[I_FGATE] + wofs, D, DFF, DFF, WSP(bf16_t, WS_WGU) + (size_t)s * NGU * D, D, 128, 256, 0, 0, ngp + (s ? 6 : 0) * D);
        TCB(in[I_FUP] + wofs, D, DFF, DFF, WSP(bf16_t, WS_WGU) + (size_t)s * NGU * D, D, 128, 256, 128, 0, ngp + (s ? 6 : 0) * D);
        TCB(in[I_FDOWN] + wofs, DFF, D, D, WSP(bf16_t, WS_WDN) + (size_t)s * D * DFF, DFF, D, 0, 0, 0, nullptr);
    }
    if (parts & 1) {
        if (even) TCB(in[I_EVIN] + (size_t)li * D * EV_IN, D, EV_IN, EV_IN, WSP(bf16_t, WS_WIN), D, EV_IN, 0, 0, 0, ngp + 2 * D);
        else { TCB(in[I_ODIN] + (size_t)li * D * 1992, D, 1992, 1992, WSP(bf16_t, WS_WIN), D, 1, 0, 0, 1, ngp + 2 * D);
            bf16_t* z = WSP(bf16_t, WS_WIN) + (size_t)456 * D; for (int i = vb * NTHREADS + C.tid; i < 56 * D; i += vg * NTHREADS) z[i] = 0; } }
    if (parts & 2) {
    TCB(in[I_XAQ] + (size_t)l * D * 512, D, 512, 512, WSP(bf16_t, WS_WQ), D, 512, 0, 0, 0, ngp + 4 * D, 0.12751743f);
    if (l == 0) {
#pragma unroll 1
        for (int ll = 0; ll < DEPTH; ++ll) {
            TCB(in[I_XAK] + (size_t)ll * D * 512, D, 512, 512, DOP(DO_WK) + (size_t)ll * 512 * D, D, 512, 0, 0, 0, nullptr);
            TCB(in[I_XAV] + (size_t)ll * D * 512, D, 512, 512, DOP(DO_WV) + (size_t)ll * 512 * D, D, 512, 0, 0, 0, nullptr); } }
    TCB(in[I_XAO] + (size_t)l * 512 * D, 512, D, D, WSP(bf16_t, WS_WO), 512, D, 0, 0, 0, nullptr);
    if (even) {
        TCB(in[I_EVOUT] + (size_t)li * D * D, D, D, D, WSP(bf16_t, WS_WOUT), D, D, 0, 0, 0, nullptr);
        tconv(C, in[I_RWW2] + (size_t)li * 64 * 512, 64, 512, 512, WSP(bf16_t, WS_W2T), 64, 512, 0, 0, 0);
        tconv(C, in[I_RWA2] + (size_t)li * 64 * 512, 64, 512, 512, WSP(bf16_t, WS_A2T), 64, 512, 0, 0, 0);
        tconv(C, in[I_RWG2] + (size_t)li * 128 * 512, 128, 512, 512, WSP(bf16_t, WS_G2T), 128, 512, 0, 0, 0);
    } else {
        const float* wout = in[I_ODOUT] + (size_t)li * D * D;
        TCB(wout + (size_t)512 * D, 512, D, D, WSP(bf16_t, WS_WOUT) + 1024, OD_Y, D, 0, 0, 0, nullptr);
        { const float* wuv = in[I_DUV] + (size_t)li * 8 * 128 * 64; bf16_t* wo = WSP(bf16_t, WS_WOUT);
          for (int idx = gtid; idx < 1024 * 1024; idx += NT) { const int n = idx & 1023, hc = idx >> 10, h = hc >> 7; const float* uv = wuv + (size_t)hc * 64; float s = 0.f;
#pragma unroll 16
              for (int d = 0; d < 64; ++d) s += uv[d] * wout[(size_t)(h * 64 + d) * D + n];
              wo[(size_t)n * OD_Y + hc] = (bf16_t)f2bf(s); } }
        { const float* wuq = in[I_DUQ] + (size_t)li * 256 * 512; const float* wuk = in[I_DUK] + (size_t)li * 8 * 64 * 128; bf16_t* wd = WSP(bf16_t, WS_WDQ);
          for (int idx = gtid; idx < 1024 * 256; idx += NT) { const int r = idx & 255, n = idx >> 8, h = n >> 7, c = n & 127; float s = 0.f;
#pragma unroll 16
              for (int d = 0; d < 64; ++d) s += wuq[(size_t)r * 512 + h * 64 + d] * wuk[(size_t)(h * 64 + d) * 128 + c];
              wd[(size_t)n * 256 + r] = (bf16_t)f2bf(s * 0.18033688f); } }
        TCB(in[I_DQI] + (size_t)li * 256 * 512, 256, 512, 512, WSP(bf16_t, WS_WDQ) + (size_t)1024 * 256, 256, 512, 0, 0, 0, nullptr);
    }
    }
#undef TCB
    if (l == 0) {
        float* rope = WSP(float, WS_ROPE);
        for (int idx = gtid; idx < SEQ * 64; idx += NT) { const int pos = idx >> 6, j = idx & 63;
            const float inv = exp2f(-(float)j * (13.287712379549449f / 64.f));
            const double ang = (double)((float)pos * inv); const double rev = ang * 0.15915494309189535; const float fr = (float)(rev - floor(rev + 0.5)) * 6.283185307179586f;
            rope[2 * idx] = __cosf(fr); rope[2 * idx + 1] = __sinf(fr); }
        const int gw = C.bid * NWAVES + C.wave, NGW = C.G * NWAVES, lane = C.lane;
        for (int m = gw; m < MM; m += NGW) { const float* xr = in[I_MEM] + (size_t)m * D; f32x4 v[4]; float ss = 0.f;
#pragma unroll
            for (int j = 0; j < 4; ++j) { v[j] = *(const f32x4*)(xr + 4 * lane + 256 * j); ss += (v[j][0] * v[j][0] + v[j][1] * v[j][1]) + (v[j][2] * v[j][2] + v[j][3] * v[j][3]); }
            const float r = 1.f / sqrtf(wave_sum(ss) * (1.f / D) + EPS);
#pragma unroll
            for (int j = 0; j < 4; ++j) { const f32x4 g = *(const f32x4*)(in[I_MEMG] + 4 * lane + 256 * j); const f32x4 o = v[j] * g * r;
                u32x2 w; w.x = pk2(o[0], o[1]); w.y = pk2(o[2], o[3]); *(u32x2*)(WSP(bf16_t, WS_MEMN) + (size_t)m * D + 4 * lane + 256 * j) = w; } }
        thin_phase(C, in[I_X], nullptr, 0.f, nullptr, nullptr);
    }
}

constexpr int RW_TC = 32;
__device__ __forceinline__ void rwkv_unit(const Ctx& C, int unit, int li) {
    const InTab in = C.in; const int b = unit >> 3, h = unit & 7, tid = C.tid, lane = C.lane, wave = C.wave, g = lane >> 4;
    const bf16_t* P = WSP(bf16_t, WS_BIG); bf16_t* Y = WSP(bf16_t, WS_Y);
    LAS float* Rl = (LAS float*)(C.lds); LAS float* Wl = Rl + RW_TC * 64; LAS float* Kl = Wl + RW_TC * 64; LAS float* Vl = Kl + RW_TC * 64; LAS float* Al = Vl + RW_TC * 64; LAS float* Bl = Al + RW_TC * 64;
    LAS float* Yl = Bl + RW_TC * 64; LAS float* Gl = Yl + RW_TC * 64; LAS float* RKl = Gl + RW_TC * 64;
    LAS bf16_t* TW = (LAS bf16_t*)(C.lds + 8 * 8192 + 256); LAS bf16_t* XA = TW + RW_TC * 72; LAS bf16_t* XG = XA + RW_TC * 72;
    const float* mu = in[I_RWMU] + (size_t)li * RW_IN;
    const float* w0 = in[I_RWW0] + li * 512 + h * 64; const float* a0 = in[I_RWA0] + li * 512 + h * 64; const float* kkp = in[I_RWKK] + li * 512 + h * 64;
    const float* kap = in[I_RWKA] + li * 512 + h * 64; const float* rkp = in[I_RWRK] + li * 512 + h * 64; const float* lng = in[I_RWLNG] + li * 512 + h * 64; const float* lnb = in[I_RWLNB] + li * 512 + h * 64;
    const int mt = wave >> 2, nt = wave & 3;
    f32x2 S2[4];
#pragma unroll
    for (int j = 0; j < 4; ++j) S2[j] = (f32x2){0.f, 0.f};
    const int tt = tid >> 4, c16 = tid & 15, c4 = c16 * 4;
    const int sv = tid >> 3, ks8 = (tid & 7) * 8;
    u32x2 cw5[5], pw5[5]; u32x4 cwg, pwg;
#define RW_LOAD(T0) do { const int t_ = (T0) + tt; const bf16_t* pr_ = P + ((size_t)b * SEQ + t_) * EV_IN; const bool hp_ = t_ > 0; const bf16_t* pp_ = pr_ - EV_IN; \
        _Pragma("unroll") for (int seg = 0; seg < 5; ++seg) { const int col = (seg < 3 ? seg * 512 + h * 64 : 1536 + (seg - 3) * 64) + c4; cw5[seg] = *(const u32x2*)(pr_ + col); pw5[seg] = (u32x2){0u, 0u}; if (hp_) pw5[seg] = *(const u32x2*)(pp_ + col); } \
        cwg = *(const u32x4*)(pr_ + 1664 + c16 * 8); pwg = (u32x4){0u, 0u, 0u, 0u}; if (hp_) pwg = *(const u32x4*)(pp_ + 1664 + c16 * 8); } while (0)
    RW_LOAD(0);
    for (int t0 = 0; t0 < SEQ; t0 += RW_TC) {
        { float ssq = 0.f; float kkv[4];
#pragma unroll
          for (int seg = 0; seg < 5; ++seg) {
              const int col = (seg < 3 ? seg * 512 + h * 64 : 1536 + (seg - 3) * 64) + c4;
              const u32x2 cw = cw5[seg], pw = pw5[seg];
              const f32x4 muv = *(const f32x4*)(mu + col);
              const float cur[4] = {bflo(cw.x), bfhi(cw.x), bflo(cw.y), bfhi(cw.y)}, prv[4] = {bflo(pw.x), bfhi(pw.x), bflo(pw.y), bfhi(pw.y)};
              float v[4];
#pragma unroll
              for (int j = 0; j < 4; ++j) v[j] = cur[j] + (prv[j] - cur[j]) * muv[j];
              if (seg == 0) { *(LAS f32x4*)(Rl + tt * 64 + c4) = (f32x4){v[0], v[1], v[2], v[3]}; }
              else if (seg == 1) { *(LAS f32x4*)(Kl + tt * 64 + c4) = (f32x4){v[0], v[1], v[2], v[3]};
#pragma unroll
                  for (int j = 0; j < 4; ++j) { kkv[j] = v[j] * kkp[c4 + j]; ssq += kkv[j] * kkv[j]; } }
              else if (seg == 2) { *(LAS f32x4*)(Vl + tt * 64 + c4) = (f32x4){v[0], v[1], v[2], v[3]}; }
              else if (seg == 3) { u32x2 o; o.x = pk2(tanhf(v[0]), tanhf(v[1])); o.y = pk2(tanhf(v[2]), tanhf(v[3])); *(LAS u32x2*)(TW + tt * 72 + c4) = o; }
              else { u32x2 o; o.x = pk2(v[0], v[1]); o.y = pk2(v[2], v[3]); *(LAS u32x2*)(XA + tt * 72 + c4) = o; }
          }
          ssq = sum16d(ssq); const float inv = 1.f / fmaxf(sqrtf(ssq), 1e-12f);
          *(LAS f32x4*)(Al + tt * 64 + c4) = (f32x4){-kkv[0] * inv, -kkv[1] * inv, -kkv[2] * inv, -kkv[3] * inv};
          { const int col = 1664 + c16 * 8; const u32x4 cw = cwg, pw = pwg;
            float o[8];
#pragma unroll
            for (int j = 0; j < 4; ++j) { const float c0 = bflo(cw[j]), c1 = bfhi(cw[j]), p0 = bflo(pw[j]), p1 = bfhi(pw[j]);
                o[2 * j] = sigmoidf_(c0 + (p0 - c0) * mu[col + 2 * j]); o[2 * j + 1] = sigmoidf_(c1 + (p1 - c1) * mu[col + 2 * j + 1]); }
            u32x4 w; w.x = pk2(o[0], o[1]); w.y = pk2(o[2], o[3]); w.z = pk2(o[4], o[5]); w.w = pk2(o[6], o[7]); *(LAS u32x4*)(XG + tt * 136 + c16 * 8) = w; }
        }
        if (t0 + RW_TC < SEQ) RW_LOAD(t0 + RW_TC);
        SYNC();
        {     bf16x8 bw2[2], ba2[2], bg2[4];
          { const int n = h * 64 + nt * 16 + (lane & 15);
#pragma unroll
            for (int ks = 0; ks < 2; ++ks) { bw2[ks] = *(const bf16x8*)(WSP(bf16_t, WS_W2T) + (size_t)n * 64 + ks * 32 + 8 * g); ba2[ks] = *(const bf16x8*)(WSP(bf16_t, WS_A2T) + (size_t)n * 64 + ks * 32 + 8 * g); }
#pragma unroll
            for (int ks = 0; ks < 4; ++ks) bg2[ks] = *(const bf16x8*)(WSP(bf16_t, WS_G2T) + (size_t)n * 128 + ks * 32 + 8 * g); }
          f32x4 aw = {0.f, 0.f, 0.f, 0.f}, aa = aw, ag = aw;
          const int ar = mt * 16 + (lane & 15);
#pragma unroll
          for (int ks = 0; ks < 2; ++ks) { const bf16x8 fa = *(const LAS bf16x8*)(TW + ar * 72 + ks * 32 + 8 * g); aw = mfma16(fa, bw2[ks], aw);
              const bf16x8 fb = *(const LAS bf16x8*)(XA + ar * 72 + ks * 32 + 8 * g); aa = mfma16(fb, ba2[ks], aa); }
#pragma unroll
          for (int ks = 0; ks < 4; ++ks) { const bf16x8 fa = *(const LAS bf16x8*)(XG + ar * 136 + ks * 32 + 8 * g); ag = mfma16(fa, bg2[ks], ag); }
          const int c = nt * 16 + (lane & 15);
#pragma unroll
          for (int i = 0; i < 4; ++i) { const int t = mt * 16 + g * 4 + i;
              const float z = -(w0[c] + aw[i]); const float sp = (z > 20.f) ? z : log1pf(__expf(z)); const float w = -sp - 0.5f;
              Wl[t * 64 + c] = __expf(-__expf(w));
              const float a = sigmoidf_(a0[c] + aa[i]); const float kraw = Kl[t * 64 + c]; const float kkn = -Al[t * 64 + c];
              Bl[t * 64 + c] = kkn * a; Kl[t * 64 + c] = kraw * (1.f + (a - 1.f) * kap[c]); Gl[t * 64 + c] = ag[i]; }
        }
        SYNC();
        { float s = 0.f;
#pragma unroll
          for (int j = 0; j < 4; ++j) s += Rl[tt * 64 + c4 + j] * Kl[tt * 64 + c4 + j] * rkp[c4 + j];
          s = sum16d(s); if (c16 == 0) RKl[tt] = s; }
        { f32x4 op[2][10]; float vv[2];
#define RW_LDS(buf, t) do { op[buf][0] = *(const LAS f32x4*)(Al + (t) * 64 + ks8); op[buf][1] = *(const LAS f32x4*)(Al + (t) * 64 + ks8 + 4); \
              op[buf][2] = *(const LAS f32x4*)(Wl + (t) * 64 + ks8); op[buf][3] = *(const LAS f32x4*)(Wl + (t) * 64 + ks8 + 4); \
              op[buf][4] = *(const LAS f32x4*)(Bl + (t) * 64 + ks8); op[buf][5] = *(const LAS f32x4*)(Bl + (t) * 64 + ks8 + 4); \
              op[buf][6] = *(const LAS f32x4*)(Kl + (t) * 64 + ks8); op[buf][7] = *(const LAS f32x4*)(Kl + (t) * 64 + ks8 + 4); \
              op[buf][8] = *(const LAS f32x4*)(Rl + (t) * 64 + ks8); op[buf][9] = *(const LAS f32x4*)(Rl + (t) * 64 + ks8 + 4); vv[buf] = Vl[(t) * 64 + sv]; } while (0)
#define RW_STEP(buf, t) do { f32x2 sa2 = {0.f, 0.f}; \
              _Pragma("unroll") for (int q = 0; q < 4; ++q) { const f32x2 a2 = {op[buf][q >> 1][2 * (q & 1)], op[buf][q >> 1][2 * (q & 1) + 1]}; sa2 = S2[q] * a2 + sa2; } \
              const float sa = sum8d(sa2.x + sa2.y); const f32x2 sav = {sa, sa}, vvv = {vv[buf], vv[buf]}; f32x2 y2 = {0.f, 0.f}; \
              _Pragma("unroll") for (int q = 0; q < 4; ++q) { const f32x2 w2 = {op[buf][2 + (q >> 1)][2 * (q & 1)], op[buf][2 + (q >> 1)][2 * (q & 1) + 1]}, b2 = {op[buf][4 + (q >> 1)][2 * (q & 1)], op[buf][4 + (q >> 1)][2 * (q & 1) + 1]}, \
                  k2 = {op[buf][6 + (q >> 1)][2 * (q & 1)], op[buf][6 + (q >> 1)][2 * (q & 1) + 1]}, r2 = {op[buf][8 + (q >> 1)][2 * (q & 1)], op[buf][8 + (q >> 1)][2 * (q & 1) + 1]}; \
                  S2[q] = S2[q] * w2 + (sav * b2 + vvv * k2); y2 = S2[q] * r2 + y2; } \
              const float y = sum8d(y2.x + y2.y); if ((tid & 7) == 0) Yl[(t) * 64 + sv] = y; } while (0)
          RW_LDS(0, 0);
#pragma unroll 2
          for (int t = 0; t < RW_TC; t += 2) {
              RW_LDS(1, t + 1);
              RW_STEP(0, t);
              if (t + 2 < RW_TC) RW_LDS(0, t + 2);
              RW_STEP(1, t + 1);
          }
        }
        SYNC();
        { const f32x4 yv = *(const LAS f32x4*)(Yl + tt * 64 + c4);
          const float mean = sum16d((yv[0] + yv[1]) + (yv[2] + yv[3])) * (1.f / 64.f);
          const f32x4 dv = yv - mean; const float var = sum16d((dv[0] * dv[0] + dv[1] * dv[1]) + (dv[2] * dv[2] + dv[3] * dv[3])) * (1.f / 64.f);
          const float rs = 1.f / sqrtf(var + RW_LN_EPS), rk = RKl[tt]; float o[4];
#pragma unroll
          for (int j = 0; j < 4; ++j) o[j] = (dv[j] * rs * lng[c4 + j] + lnb[c4 + j] + rk * Vl[tt * 64 + c4 + j]) * Gl[tt * 64 + c4 + j];
          u32x2 w; w.x = pk2(o[0], o[1]); w.y = pk2(o[2], o[3]);
          *(u32x2*)(Y + ((size_t)b * SEQ + t0 + tt) * D + h * 64 + c4) = w; }
        SYNC();
    }
}

constexpr int RC_L = 16;
__device__ __forceinline__ float tanh_fast(float x) { return 1.f - 2.f * frcp(__expf(2.f * x) + 1.f); }
__device__ __forceinline__ bf16x8 frag2(u32x2 lo, u32x2 hi) { return __builtin_bit_cast(bf16x8, (u32x4){lo.x, lo.y, hi.x, hi.y}); }
__device__ __forceinline__ u32x2 pack4(const f32x4 v) { u32x2 o; o.x = pk2(v[0], v[1]); o.y = pk2(v[2], v[3]); return o; }
__device__ __forceinline__ void rwkv_unit2(const Ctx& C, int unit, int li) {
    const InTab in = C.in; const int b = unit >> 3, h = unit & 7, tid = C.tid, lane = C.lane, wave = C.wave, g = lane >> 4, lr = lane & 15;
    const bf16_t* P = WSP(bf16_t, WS_BIG); bf16_t* Y = WSP(bf16_t, WS_Y);
    constexpr int OPB = 23040;
    LAS unsigned char* L0 = C.lds;
#define OP_AT(p) ((LAS bf16_t*)(L0 + (p) * OPB))
#define OP_RT(p) (OP_AT(p) + 16 * 72)
#define OP_BT(p) (OP_AT(p) + 2 * 16 * 72)
#define OP_KT(p) (OP_AT(p) + 3 * 16 * 72)
#define OP_BTT(p) (OP_AT(p) + 4 * 16 * 72)
#define OP_KTT(p) (OP_BTT(p) + 64 * 24)
#define OP_VTB(p) (OP_BTT(p) + 2 * 64 * 24)
#define OP_GL(p) ((LAS float*)(L0 + (p) * OPB + 18432))
#define OP_GF(p) (OP_GL(p) + 64)
#define OP_RKP(p) (OP_GL(p) + 64 + 1024)
    LAS bf16_t* MsT = (LAS bf16_t*)(L0 + 2 * OPB); LAS bf16_t* TT = MsT + 16 * 24; LAS bf16_t* NRT = TT + 16 * 24; LAS bf16_t* MRT = NRT + 16 * 24;
    LAS bf16_t* TW = MRT + 16 * 24; LAS bf16_t* XA = TW + 16 * 72; LAS bf16_t* XG = XA + 16 * 72;
    LAS float* Yl = (LAS float*)(L0 + 2 * OPB + 12288); LAS float* NF = Yl + 7168; LAS float* GW = NF + 256;   LAS float* Rf = Yl + 1024; LAS float* Kf = Rf + 1024; LAS float* AK = Kf + 1024; LAS float* Vf = AK + 1024;
    const float* mu = in[I_RWMU] + (size_t)li * RW_IN;
    const float* w0 = in[I_RWW0] + li * 512 + h * 64; const float* a0 = in[I_RWA0] + li * 512 + h * 64; const float* kkp = in[I_RWKK] + li * 512 + h * 64;
    const float* kap = in[I_RWKA] + li * 512 + h * 64; const float* rkp = in[I_RWRK] + li * 512 + h * 64; const float* lng = in[I_RWLNG] + li * 512 + h * 64; const float* lnb = in[I_RWLNB] + li * 512 + h * 64;
    const int pw = wave & 3;
    bf16x8 bwa[2], bg2[4];
    { const int n = h * 64 + pw * 16 + lr; const bf16_t* wsel = (wave < 4) ? WSP(bf16_t, WS_W2T) : WSP(bf16_t, WS_A2T);
#pragma unroll
      for (int ks = 0; ks < 2; ++ks) bwa[ks] = *(const bf16x8*)(wsel + (size_t)n * 64 + ks * 32 + 8 * g);
#pragma unroll
      for (int ks = 0; ks < 4; ++ks) bg2[ks] = *(const bf16x8*)(WSP(bf16_t, WS_G2T) + (size_t)n * 128 + ks * 32 + 8 * g); }
    f32x4 zt[4];
#pragma unroll
    for (int i = 0; i < 4; ++i) zt[i] = (f32x4){0.f, 0.f, 0.f, 0.f};
    const int tt = tid >> 5, c32 = tid & 31, c2 = c32 * 2;
    float mu5[5][2], mug[4];
#pragma unroll
    for (int seg = 0; seg < 5; ++seg) { const int col = (seg < 3 ? seg * 512 + h * 64 : 1536 + (seg - 3) * 64) + c2; mu5[seg][0] = mu[col]; mu5[seg][1] = mu[col + 1]; }
#pragma unroll
    for (int j = 0; j < 4; ++j) mug[j] = mu[1664 + c32 * 4 + j];
    const float kk0 = kkp[c2], kk1 = kkp[c2 + 1], lng0 = lng[c2], lng1 = lng[c2 + 1], lnb0 = lnb[c2], lnb1 = lnb[c2 + 1];
    const float w0c = w0[pw * 16 + lr], a0c = a0[pw * 16 + lr], kac = kap[pw * 16 + lr], rkc = rkp[pw * 16 + lr];
    float kk0s, kk1s, lng0s, lng1s, lnb0s, lnb1s, w0cs, a0cs, kacs, rkcs;
    LAS unsigned char* RING = L0 + 100352;
    unsigned doff[2];
#pragma unroll
    for (int j = 0; j < 2; ++j) { const int q = 16 * wave + 8 * j + (lane >> 3), r = q / 7, ln = q % 7; doff[j] = (unsigned)(r * EV_IN + (ln < 3 ? ln * 512 + h * 64 : 1536 + (ln - 3) * 64) + (lane & 7) * 8); }
    const bf16_t* Pb = P + (size_t)b * SEQ * EV_IN;
#define RC_DMA(CI) do { if (wave < 7) { const bf16_t* src_ = Pb + (unsigned)((CI) * RC_L * EV_IN); LAS unsigned char* dst_ = RING + ((CI) % 3) * (16 * 896) + wave * 2048; \
        glds16(src_ + doff[0], dst_); glds16(src_ + doff[1], dst_ + 1024); } } while (0)
#define RC_POST(CI) do { const int pp_ = (CI) & 1; const f32x2 yv = *(const LAS f32x2*)(Yl + tt * 64 + c2); float sm = yv.x + yv.y; sm = xr16_sum(sum16d(sm)); const float mean = sm * (1.f / 64.f); \
        const float d0 = yv.x - mean, d1 = yv.y - mean; float vq = d0 * d0 + d1 * d1; vq = xr16_sum(sum16d(vq)); const float rs = frsq(vq * (1.f / 64.f) + RW_LN_EPS); \
        const LAS float* rp_ = OP_RKP(pp_) + tt; const float rk = (rp_[0] + rp_[16]) + (rp_[32] + rp_[48]); const LAS float* vf_ = Vf + ((CI) % 3) * 1024 + tt * 64 + c2; const LAS float* gf_ = OP_GF(pp_) + tt * 64 + c2; \
        const float o0 = (d0 * rs * lng0s + lnb0s + rk * vf_[0]) * gf_[0], o1 = (d1 * rs * lng1s + lnb1s + rk * vf_[1]) * gf_[1]; \
        *(unsigned*)(Y + ((size_t)b * SEQ + (CI) * RC_L + tt) * D + h * 64 + c2) = pk2(o0, o1); } while (0)
#define RC_LERP(CI) do { float vv[5][2]; unsigned cw5[5], pw5[5]; u32x2 cwg, pwg; \
        { const int s0_ = ((CI) % 3) * 16 + tt; const LAS unsigned char* rw_ = RING + s0_ * 896 + c32 * 4; const LAS unsigned char* rp_ = RING + (s0_ == 0 ? 47 : s0_ - 1) * 896 + c32 * 4; const bool hp_ = ((CI) * RC_L + tt) > 0; \
          _Pragma("unroll") for (int seg = 0; seg < 5; ++seg) { cw5[seg] = *(const LAS unsigned*)(rw_ + seg * 128); pw5[seg] = hp_ ? *(const LAS unsigned*)(rp_ + seg * 128) : 0u; } \
          cwg = *(const LAS u32x2*)(rw_ + 640 + c32 * 4); pwg = hp_ ? *(const LAS u32x2*)(rp_ + 640 + c32 * 4) : (u32x2){0u, 0u}; } \
        _Pragma("unroll") for (int seg = 0; seg < 5; ++seg) { const float c0 = bflo(cw5[seg]), c1 = bfhi(cw5[seg]), p0 = bflo(pw5[seg]), p1 = bfhi(pw5[seg]); vv[seg][0] = c0 + (p0 - c0) * mu5[seg][0]; vv[seg][1] = c1 + (p1 - c1) * mu5[seg][1]; } \
        *(LAS f32x2*)(Rf + tt * 64 + c2) = (f32x2){vv[0][0], vv[0][1]}; *(LAS f32x2*)(Kf + tt * 64 + c2) = (f32x2){vv[1][0], vv[1][1]}; \
        const float k0 = vv[1][0] * kk0s, k1 = vv[1][1] * kk1s; float ssq = k0 * k0 + k1 * k1; ssq = xr16_sum(sum16d(ssq)); const float inv = frsq(fmaxf(ssq, 1e-24f)); \
        *(LAS f32x2*)(AK + tt * 64 + c2) = (f32x2){-k0 * inv, -k1 * inv}; *(LAS f32x2*)(Vf + ((CI) % 3) * 1024 + tt * 64 + c2) = (f32x2){vv[2][0], vv[2][1]}; \
        LAS bf16_t* vtb_ = OP_VTB((CI) & 1); vtb_[c2 * 24 + tt] = (bf16_t)f2bf(vv[2][0]); vtb_[(c2 + 1) * 24 + tt] = (bf16_t)f2bf(vv[2][1]); \
        *(LAS unsigned*)(TW + tt * 72 + c2) = pk2(tanh_fast(vv[3][0]), tanh_fast(vv[3][1])); *(LAS unsigned*)(XA + tt * 72 + c2) = pk2(vv[4][0], vv[4][1]); \
        float o_[4]; _Pragma("unroll") for (int j = 0; j < 2; ++j) { const float c0 = bflo(cwg[j]), c1 = bfhi(cwg[j]), p0 = bflo(pwg[j]), p1 = bfhi(pwg[j]); \
            o_[2 * j] = sigmoidf_(c0 + (p0 - c0) * mug[2 * j]); o_[2 * j + 1] = sigmoidf_(c1 + (p1 - c1) * mug[2 * j + 1]); } \
        u32x2 w_; w_.x = pk2(o_[0], o_[1]); w_.y = pk2(o_[2], o_[3]); *(LAS u32x2*)(XG + tt * 136 + c32 * 4) = w_; } while (0)
#define RC_WPATH(CI) do { const int p_ = (CI) & 1; f32x4 aw = {0.f, 0.f, 0.f, 0.f}; \
        _Pragma("unroll") for (int ks = 0; ks < 2; ++ks) aw = mfma16(*(const LAS bf16x8*)(TW + lr * 72 + ks * 32 + 8 * g), bwa[ks], aw); \
        const int c = pw * 16 + lr; float e[4], cs[4]; \
        _Pragma("unroll") for (int i = 0; i < 4; ++i) { const float z = -(w0cs + aw[i]); const float sp = (z > 20.f) ? z : __logf(1.f + __expf(z)); e[i] = __expf(-sp - 0.5f); cs[i] = e[i] + (i ? cs[i - 1] : 0.f); } \
        const float tot = cs[3]; float ta_, tb_, pa_, pb_; xr16_pair(tot, ta_, tb_); xr32_pair(ta_ + tb_, pa_, pb_);            \
        const float base = ((g & 1) ? ta_ : 0.f) + ((g & 2) ? pa_ : 0.f); \
        _Pragma("unroll") for (int i = 0; i < 4; ++i) { const int t = 4 * g + i; const float cum = base + cs[i]; const float Gt = __expf(-cum); \
            GW[t * 64 + c] = Gt; GW[1024 + t * 64 + c] = __expf(-(cum - e[i])); GW[2048 + t * 64 + c] = __expf(cum); if (g == 3 && i == 3) OP_GL(p_)[c] = Gt; } } while (0)
#define RC_APATH1(CI) do { const int p_ = (CI) & 1; f32x4 aa = {0.f, 0.f, 0.f, 0.f}; \
        _Pragma("unroll") for (int ks = 0; ks < 2; ++ks) aa = mfma16(*(const LAS bf16x8*)(XA + lr * 72 + ks * 32 + 8 * g), bwa[ks], aa); \
        const int c = pw * 16 + lr; \
        _Pragma("unroll") for (int i = 0; i < 4; ++i) { const int t = 4 * g + i; const float alr = sigmoidf_(a0cs + aa[i]); const float kraw = Kf[t * 64 + c]; ap_kkn[i] = -AK[t * 64 + c]; ap_rr[i] = Rf[t * 64 + c]; \
            ap_kfin[i] = kraw * (1.f + (alr - 1.f) * kacs); ap_bt[i] = ap_kkn[i] * alr; \
            float rk = ap_rr[i] * ap_kfin[i] * rkcs; rk = sum16d(rk); if (lr == 0) OP_RKP(p_)[pw * 16 + t] = rk; } } while (0)
#define RC_APATH2(CI) do { const int p_ = (CI) & 1; const int c = pw * 16 + lr; LAS bf16_t* At_ = OP_AT(p_); LAS bf16_t* Rt_ = OP_RT(p_); LAS bf16_t* Bt_ = OP_BT(p_); LAS bf16_t* Kt_ = OP_KT(p_); f32x4 bq, kq; \
        _Pragma("unroll") for (int i = 0; i < 4; ++i) { const int t = 4 * g + i; const float Gt = GW[t * 64 + c], Gp = GW[1024 + t * 64 + c], iG = GW[2048 + t * 64 + c]; \
            const float bt = ap_bt[i] * iG, kt = ap_kfin[i] * iG; bq[i] = bt; kq[i] = kt; \
            At_[t * 72 + c] = (bf16_t)f2bf(-ap_kkn[i] * Gp); Rt_[t * 72 + c] = (bf16_t)f2bf(ap_rr[i] * Gt); Bt_[t * 72 + c] = (bf16_t)f2bf(bt); Kt_[t * 72 + c] = (bf16_t)f2bf(kt); } \
        *(LAS u32x2*)(OP_BTT(p_) + c * 24 + 4 * g) = pack4(bq); *(LAS u32x2*)(OP_KTT(p_) + c * 24 + 4 * g) = pack4(kq); } while (0)
    WAIT_VM(0);
    LAUNDER_V(bwa[0]); LAUNDER_V(bwa[1]); LAUNDER_V(bg2[0]); LAUNDER_V(bg2[1]); LAUNDER_V(bg2[2]); LAUNDER_V(bg2[3]);
#pragma unroll
    for (int seg = 0; seg < 5; ++seg) { LAUNDER_V(mu5[seg][0]); LAUNDER_V(mu5[seg][1]); }
#pragma unroll
    for (int j = 0; j < 4; ++j) LAUNDER_V(mug[j]);
    { float k0_ = kk0, k1_ = kk1, g0_ = lng0, g1_ = lng1, b0_ = lnb0, b1_ = lnb1, w_ = w0c, a_ = a0c, ka_ = kac, rk_ = rkc;
      LAUNDER_V(k0_); LAUNDER_V(k1_); LAUNDER_V(g0_); LAUNDER_V(g1_); LAUNDER_V(b0_); LAUNDER_V(b1_); LAUNDER_V(w_); LAUNDER_V(a_); LAUNDER_V(ka_); LAUNDER_V(rk_);
      kk0s = k0_; kk1s = k1_; lng0s = g0_; lng1s = g1_; lnb0s = b0_; lnb1s = b1_; w0cs = w_; a0cs = a_; kacs = ka_; rkcs = rk_; }
#define RC_GATE(CI) do { f32x4 ag = {0.f, 0.f, 0.f, 0.f}; _Pragma("unroll") for (int ks = 0; ks < 4; ++ks) ag = mfma16(*(const LAS bf16x8*)(XG + lr * 136 + ks * 32 + 8 * g), bg2[ks], ag); \
        _Pragma("unroll") for (int i = 0; i < 4; ++i) OP_GF((CI) & 1)[(4 * g + i) * 64 + pw * 16 + lr] = ag[i]; } while (0)
    constexpr int NCH = SEQ / RC_L;
    RC_DMA(0); RC_DMA(1); WAIT_VM(0); LSYNC();
#pragma unroll 1
    for (int ci = -1; ci <= NCH; ++ci) {
        const int par = ci & 1;
        if (ci + 1 < NCH) RC_LERP(ci + 1);
        if (ci >= 1) RC_POST(ci - 1);
        LSYNC();
        if (ci + 3 < NCH) RC_DMA(ci + 3);
        if (wave >= 4) { float ap_kkn[4], ap_rr[4], ap_kfin[4], ap_bt[4]; if (ci + 1 < NCH) RC_APATH1(ci + 1); LSYNC(); if (ci + 1 < NCH) RC_APATH2(ci + 1); }
        else if (ci < 0 || ci >= NCH) { if (ci + 1 < NCH) { RC_GATE(ci + 1); RC_WPATH(ci + 1); } LSYNC(); }
        else {
            if (ci + 1 < NCH) { RC_GATE(ci + 1); RC_WPATH(ci + 1); }
            { const LAS bf16_t* Xo = (wave & 1) ? OP_KT(par) : OP_BT(par); const LAS bf16_t* Yo = (wave >> 1) ? OP_RT(par) : OP_AT(par); f32x4 acc = {0.f, 0.f, 0.f, 0.f};
#pragma unroll
              for (int ks = 0; ks < 2; ++ks) acc = mfma16(*(const LAS bf16x8*)(Xo + lr * 72 + ks * 32 + 8 * g), *(const LAS bf16x8*)(Yo + lr * 72 + ks * 32 + 8 * g), acc);
#pragma unroll
              for (int i = 0; i < 4; ++i) { const int j = 4 * g + i; const bool keep = (wave < 2) ? (j < lr) : (j <= lr); acc[i] = keep ? acc[i] : 0.f; }
              if (wave == 0) {
                  *(LAS u32x2*)(TT + lr * 24 + 4 * g) = pack4(acc);
#pragma unroll
                  for (int i = 0; i < 4; ++i) NF[(4 * g + i) * 16 + lr] = acc[i];
              } else { LAS bf16_t* img = (wave == 1) ? MsT : ((wave == 2) ? NRT : MRT); *(LAS u32x2*)(img + lr * 24 + 4 * g) = pack4(acc); } }
            LSYNC();
            { const LAS bf16_t* AtL = OP_AT(par); const LAS bf16_t* RtL = OP_RT(par); const LAS bf16_t* BtT = OP_BTT(par); const LAS bf16_t* KtT = OP_KTT(par); const LAS float* GLf = OP_GL(par);
              const int vrow = wave * 16 + lr; const u32x2 zero2 = {0u, 0u};
              bf16x8 zb[2];
#pragma unroll
              for (int s2 = 0; s2 < 2; ++s2) zb[s2] = frag2(pack4(zt[2 * s2]), pack4(zt[2 * s2 + 1]));
              const u32x2 vfr = *(const LAS u32x2*)(OP_VTB(par) + vrow * 24 + 4 * g);
              f32x4 rhs = {0.f, 0.f, 0.f, 0.f}, yv = rhs;
#pragma unroll
              for (int s2 = 0; s2 < 2; ++s2) { rhs = mfma16(frag2(*(const LAS u32x2*)(AtL + lr * 72 + 32 * s2 + 4 * g), *(const LAS u32x2*)(AtL + lr * 72 + 32 * s2 + 16 + 4 * g)), zb[s2], rhs);
                  yv = mfma16(frag2(*(const LAS u32x2*)(RtL + lr * 72 + 32 * s2 + 4 * g), *(const LAS u32x2*)(RtL + lr * 72 + 32 * s2 + 16 + 4 * g)), zb[s2], yv); }
              rhs = mfma16(frag2(zero2, *(const LAS u32x2*)(MsT + lr * 24 + 4 * g)), frag2(zero2, vfr), rhs);
              const float n01 = NF[(4 * g) * 16 + 4 * g + 1], n02 = NF[(4 * g) * 16 + 4 * g + 2], n03 = NF[(4 * g) * 16 + 4 * g + 3], n12 = NF[(4 * g + 1) * 16 + 4 * g + 2], n13 = NF[(4 * g + 1) * 16 + 4 * g + 3], n23 = NF[(4 * g + 2) * 16 + 4 * g + 3];
              const bf16x8 nsf = frag2(*(const LAS u32x2*)(TT + lr * 24 + 4 * g), zero2);
              f32x4 sa = {0.f, 0.f, 0.f, 0.f};
#pragma unroll
              for (int g0 = 0; g0 < 4; ++g0) { const f32x4 ac = mfma16(nsf, frag2(pack4(sa), zero2), rhs);
                  if (g == g0) { sa[0] = ac[0]; sa[1] = ac[1] + sa[0] * n01; sa[2] = ac[2] + sa[0] * n02 + sa[1] * n12; sa[3] = ac[3] + sa[0] * n03 + sa[1] * n13 + sa[2] * n23; } }
              const bf16x8 svf = frag2(pack4(sa), vfr);
              yv = mfma16(frag2(*(const LAS u32x2*)(NRT + lr * 24 + 4 * g), *(const LAS u32x2*)(MRT + lr * 24 + 4 * g)), svf, yv);
#pragma unroll
              for (int i = 0; i < 4; ++i) Yl[(4 * g + i) * 64 + vrow] = yv[i];
#pragma unroll
              for (int kt = 0; kt < 4; ++kt) { zt[kt] = mfma16(frag2(*(const LAS u32x2*)(BtT + (kt * 16 + lr) * 24 + 4 * g), *(const LAS u32x2*)(KtT + (kt * 16 + lr) * 24 + 4 * g)), svf, zt[kt]);
                  zt[kt] = zt[kt] * *(const LAS f32x4*)(GLf + kt * 16 + 4 * g); } }
        }
        if (ci + 3 < NCH) WAIT_VM(2); else WAIT_VM(0);
        LSYNC();
    }
#undef RC_DMA
#undef RC_POST
#undef RC_LERP
#undef RC_WPATH
#undef RC_APATH1
#undef RC_APATH2
#undef RC_GATE
}

constexpr int RT_LD = 136;
__device__ __forceinline__ void ret_stage_k(const Ctx& C, const bf16_t* P, const float* rope, int b, int h, int t0, LAS bf16_t* KS, bool transposed, float lg2) {
    const int j = C.tid >> 2, dseg = (C.tid & 3) * 16; const size_t m = (size_t)b * SEQ + t0 + j;
    const bf16_t* kr = P + m * EV_IN + RW_IN + 512 + h * 128;
    const float zs = transposed ? exp2f((float)(127 - j) * lg2) * 0.08838834764831845f : 0.08838834764831845f;
    float x1[16], x2[16];
#pragma unroll
    for (int q = 0; q < 2; ++q) { const u32x4 a = *(const u32x4*)(kr + dseg + 8 * q), c = *(const u32x4*)(kr + 64 + dseg + 8 * q);
#pragma unroll
        for (int e = 0; e < 4; ++e) { x1[8 * q + 2 * e] = bflo(a[e]); x1[8 * q + 2 * e + 1] = bfhi(a[e]); x2[8 * q + 2 * e] = bflo(c[e]); x2[8 * q + 2 * e + 1] = bfhi(c[e]); } }
    const float* rp = rope + ((size_t)(t0 + j) * 64 + dseg) * 2;
    float y1[16], y2[16];
#pragma unroll
    for (int e = 0; e < 16; ++e) { const float cs = rp[2 * e], sn = rp[2 * e + 1]; y1[e] = (x1[e] * cs - x2[e] * sn) * zs; y2[e] = (x1[e] * sn + x2[e] * cs) * zs; }
    if (!transposed) {
#pragma unroll
        for (int q = 0; q < 2; ++q) { u32x4 o1, o2;
#pragma unroll
            for (int e = 0; e < 4; ++e) { o1[e] = pk2(y1[8 * q + 2 * e], y1[8 * q + 2 * e + 1]); o2[e] = pk2(y2[8 * q + 2 * e], y2[8 * q + 2 * e + 1]); }
            *(LAS u32x4*)(KS + j * RT_LD + dseg + 8 * q) = o1; *(LAS u32x4*)(KS + j * RT_LD + 64 + dseg + 8 * q) = o2; }
    } else {
#pragma unroll
        for (int e = 0; e < 16; ++e) { KS[(dseg + e) * RT_LD + j] = (bf16_t)f2bf(y1[e]); KS[(64 + dseg + e) * RT_LD + j] = (bf16_t)f2bf(y2[e]); }
    }
}
__device__ __forceinline__ void ret_unit(const Ctx& C, int unit, int li) {
    const InTab in = C.in; const int b = unit >> 2, h = unit & 3, tid = C.tid, lane = C.lane, w = C.wave, g = lane >> 4, lr = lane & 15;
    const bf16_t* P = WSP(bf16_t, WS_BIG); bf16_t* Y = WSP(bf16_t, WS_Y); const float* rope = WSP(float, WS_ROPE);
    LAS bf16_t* KS = (LAS bf16_t*)C.lds; LAS bf16_t* VT = KS + 128 * RT_LD; LAS bf16_t* RT = VT + 128 * RT_LD; LAS bf16_t* PW = RT + 128 * RT_LD + w * (16 * 40);
    const float gx = __builtin_bit_cast(float, (122 - h) << 23);
    const float lg2 = -gx * (1.f + gx * (0.5f + gx * (0.333333333f + gx * (0.25f + gx * (0.2f + gx * 0.166666667f))))) * 1.4426950408889634f;
    const float cg = exp2f(128.f * lg2);
    const float* gg = in[I_RTG] + li * 512 + h * 128; const float* gb = in[I_RTB] + li * 512 + h * 128;
    f32x4 racc[8];
#pragma unroll
    for (int i = 0; i < 8; ++i) racc[i] = (f32x4){0.f, 0.f, 0.f, 0.f};
    for (int n = 0; n < SEQ / 128; ++n) {
        const int t0 = n * 128; const size_t m0 = (size_t)b * SEQ + t0;
        ret_stage_k(C, P, rope, b, h, t0, KS, false, lg2);
        { const int j = tid >> 2, es = (tid & 3) * 32; const bf16_t* vr = P + (m0 + j) * EV_IN + RW_IN + 1024 + h * 128 + es;
#pragma unroll
          for (int q = 0; q < 4; ++q) { const u32x4 a = *(const u32x4*)(vr + 8 * q);
#pragma unroll
              for (int e = 0; e < 4; ++e) { VT[(es + 8 * q + 2 * e) * RT_LD + j] = (bf16_t)(a[e] & 0xffffu); VT[(es + 8 * q + 2 * e + 1) * RT_LD + j] = (bf16_t)(a[e] >> 16); } } }
        bf16x8 qa[4];
        { const int i = 16 * w + lr; const bf16_t* qr = P + (m0 + i) * EV_IN + RW_IN + h * 128; const float* rp = rope + (size_t)(t0 + i) * 128;
          float x[4][8];
#pragma unroll
          for (int ks = 0; ks < 4; ++ks) { const u32x4 a = *(const u32x4*)(qr + 32 * ks + 8 * g);
#pragma unroll
              for (int e = 0; e < 4; ++e) { x[ks][2 * e] = bflo(a[e]); x[ks][2 * e + 1] = bfhi(a[e]); } }
#pragma unroll
          for (int ks = 0; ks < 2; ++ks) {
#pragma unroll
              for (int e = 0; e < 8; ++e) { const int d = 32 * ks + 8 * g + e; const float cs = rp[2 * d], sn = rp[2 * d + 1]; const float a1 = x[ks][e], a2 = x[ks + 2][e];
                  x[ks][e] = a1 * cs - a2 * sn; x[ks + 2][e] = a1 * sn + a2 * cs; } }
#pragma unroll
          for (int ks = 0; ks < 4; ++ks) { u32x4 o;
#pragma unroll
              for (int e = 0; e < 4; ++e) o[e] = pk2(x[ks][2 * e], x[ks][2 * e + 1]);
              qa[ks] = __builtin_bit_cast(bf16x8, o); } }
        SYNC();
        f32x4 oacc[8];
#pragma unroll
        for (int i = 0; i < 8; ++i) oacc[i] = (f32x4){0.f, 0.f, 0.f, 0.f};
        const int npair = (w >> 1) + 1;
        for (int kk = 0; kk < npair; ++kk) {
#pragma unroll
            for (int hf = 0; hf < 2; ++hf) { const int nt = 2 * kk + hf; f32x4 acc = {0.f, 0.f, 0.f, 0.f};
#pragma unroll
                for (int ks = 0; ks < 4; ++ks) acc = mfma16(qa[ks], *(const LAS bf16x8*)(KS + (nt * 16 + lr) * RT_LD + 32 * ks + 8 * g), acc);
#pragma unroll
                for (int r = 0; r < 4; ++r) { const int il = 16 * w + 4 * g + r, jl = nt * 16 + lr; const float v = (il >= jl) ? acc[r] * exp2f((float)(il - jl) * lg2) : 0.f;
                    PW[(4 * g + r) * 40 + hf * 16 + lr] = (bf16_t)f2bf(v); } }
            WAIT_LGKM(0);
            const bf16x8 pa = *(const LAS bf16x8*)(PW + lr * 40 + 8 * g);
#pragma unroll
            for (int nv = 0; nv < 8; ++nv) oacc[nv] = mfma16(pa, *(const LAS bf16x8*)(VT + (nv * 16 + lr) * RT_LD + kk * 32 + 8 * g), oacc[nv]);
        }
        if (n > 0) {
#pragma unroll
            for (int nv = 0; nv < 8; ++nv) { f32x4 c = {0.f, 0.f, 0.f, 0.f};
#pragma unroll
                for (int ks = 0; ks < 4; ++ks) c = mfma16(qa[ks], *(const LAS bf16x8*)(RT + (nv * 16 + lr) * RT_LD + 32 * ks + 8 * g), c);
#pragma unroll
                for (int r = 0; r < 4; ++r) oacc[nv][r] += c[r] * exp2f((float)(16 * w + 4 * g + r + 1) * lg2); }
        }
#pragma unroll
        for (int r = 0; r < 4; ++r) { float s = 0.f;
#pragma unroll
            for (int nv = 0; nv < 8; ++nv) s += oacc[nv][r];
            const float mean = sum16d(s) * (1.f / 128.f); float q = 0.f;
#pragma unroll
            for (int nv = 0; nv < 8; ++nv) { const float d = oacc[nv][r] - mean; q += d * d; }
            const float rs = frsq(sum16d(q) * (1.f / 128.f) + EPS);
            const size_t m = m0 + 16 * w + 4 * g + r; const bf16_t* gr = P + m * EV_IN + RW_IN + 1536 + h * 128;
#pragma unroll
            for (int nv = 0; nv < 8; ++nv) { const int e = nv * 16 + lr; const float gv = bf2f(gr[e]); const float o = (oacc[nv][r] - mean) * rs * gg[e] + gb[e];
                Y[m * D + 512 + h * 128 + e] = (bf16_t)f2bf(gv * sigmoidf_(gv) * o); } }
        SYNC();
        ret_stage_k(C, P, rope, b, h, t0, KS, true, lg2);
        SYNC();
#pragma unroll
        for (int dk = 0; dk < 8; ++dk) { f32x4 c = racc[dk] * cg;
#pragma unroll
            for (int ks = 0; ks < 4; ++ks) c = mfma16(*(const LAS bf16x8*)(VT + (16 * w + lr) * RT_LD + 32 * ks + 8 * g), *(const LAS bf16x8*)(KS + (dk * 16 + lr) * RT_LD + 32 * ks + 8 * g), c);
            racc[dk] = c;
#pragma unroll
            for (int r = 0; r < 4; ++r) RT[(16 * w + 4 * g + r) * RT_LD + dk * 16 + lr] = (bf16_t)f2bf(c[r]); }
        SYNC();
    }
}

__device__ __forceinline__ void dsa_prep_phase(const Ctx& C, int li) {
    const InTab in = C.in; const bf16_t* P = WSP(bf16_t, WS_BIG); const int lane = C.lane;
    const int gw = C.bid * NWAVES + C.wave, NGW = C.G * NWAVES;
    const float* qg = in[I_DQG] + li * 256; const float* kvg = in[I_DKVG] + li * 128;
    constexpr int PR = 8;
    float qgv[4], kgv[2];
#pragma unroll
    for (int k = 0; k < 4; ++k) qgv[k] = qg[4 * lane + k];
    kgv[0] = kvg[2 * lane]; kgv[1] = kvg[2 * lane + 1];
    LAS bf16_t* TT_ = (LAS bf16_t*)C.lds; constexpr int TLD = 66;
    for (int tile = C.bid; tile < M / 64; tile += C.G) {
      for (int hs = 0; hs < 8 / PR; ++hs) { const int m0 = tile * 64 + C.wave * 8 + hs * PR;
        u32x2 av[PR]; unsigned kwv[PR], kiv[PR]; float wiv[PR];
#pragma unroll
        for (int r = 0; r < PR; ++r) { const bf16_t* pr = P + (size_t)(m0 + r) * OD_INP; av[r] = *(const u32x2*)(pr + 4 * lane); kwv[r] = *(const unsigned*)(pr + 256 + 2 * lane);
            kiv[r] = (lane < 32) ? *(const unsigned*)(pr + 384 + 2 * lane) : 0u; wiv[r] = (lane < 8) ? bf2f(pr[448 + lane]) : 0.f; }
#pragma unroll
        for (int r = 0; r < PR; ++r) { const int m = m0 + r;
            const float q[4] = {bflo(av[r].x), bfhi(av[r].x), bflo(av[r].y), bfhi(av[r].y)};
            const float rq = frsq(wave_sum((q[0] * q[0] + q[1] * q[1]) + (q[2] * q[2] + q[3] * q[3])) * (1.f / 256.f) + EPS);
            u32x2 o; o.x = pk2(q[0] * rq * qgv[0], q[1] * rq * qgv[1]); o.y = pk2(q[2] * rq * qgv[2], q[3] * rq * qgv[3]);
            *(u32x2*)(WSP(bf16_t, WS_CQN) + (size_t)m * 256 + 4 * lane) = o;
            const float k0 = bflo(kwv[r]), k1 = bfhi(kwv[r]);
            const float rk = frsq(wave_sum(k0 * k0 + k1 * k1) * (1.f / 128.f) + EPS);
            const unsigned ko = pk2(k0 * rk * kgv[0], k1 * rk * kgv[1]);
            *(unsigned*)(WSP(bf16_t, WS_CKV) + (size_t)m * 128 + 2 * lane) = ko;
            { const int tl = C.wave * 8 + hs * PR + r; TT_[(2 * lane) * TLD + tl] = (bf16_t)(ko & 0xffffu); TT_[(2 * lane + 1) * TLD + tl] = (bf16_t)(ko >> 16); }
            if (lane < 8) WSP(float, WS_WI)[(size_t)m * 8 + lane] = wiv[r] * 0.044194173824159216f;
            if (lane < 32) *(unsigned*)(WSP(bf16_t, WS_KI) + (size_t)m * 64 + 2 * lane) = kiv[r]; }
      }
      LSYNC();
      { const int col = C.tid >> 2, seg = C.tid & 3, bb = (tile * 64) / SEQ, t0 = (tile * 64) % SEQ; const LAS unsigned* src = (const LAS unsigned*)(TT_ + col * TLD + seg * 16); u32x4 a, b2;
        a.x = src[0]; a.y = src[1]; a.z = src[2]; a.w = src[3]; b2.x = src[4]; b2.y = src[5]; b2.z = src[6]; b2.w = src[7];
        bf16_t* ct = WSP(bf16_t, WS_CKVT) + ((size_t)bb * 128 + col) * SEQ + t0 + seg * 16; *(u32x4*)ct = a; *(u32x4*)(ct + 8) = b2; }
      LSYNC();
    }
    const float* cw = in[I_SCW] + (size_t)li * 3 * 512; const float* cb = in[I_SCB] + li * 512; bf16_t* Y = WSP(bf16_t, WS_Y);
    const int gtid = C.bid * NTHREADS + C.tid, NT = C.G * NTHREADS;
    for (int idx = gtid; idx < M * 64; idx += NT) { const int m = idx >> 6, c8 = (idx & 63) * 8, t = m % SEQ; const bf16_t* pr = P + (size_t)m * OD_INP;
        float y[8];
#pragma unroll
        for (int j = 0; j < 8; ++j) y[j] = cb[c8 + j];
#pragma unroll
        for (int k = 0; k < 3; ++k) { const int dt = 2 - k; if (t - dt >= 0) { const bf16_t* pk = pr - (size_t)dt * OD_INP; const u32x4 hh = *(const u32x4*)(pk + 512 + c8), gc = *(const u32x4*)(pk + 1536 + c8);
#pragma unroll
                for (int e = 0; e < 4; ++e) { y[2 * e] += cw[k * 512 + c8 + 2 * e] * bflo(hh[e]) * bflo(gc[e]); y[2 * e + 1] += cw[k * 512 + c8 + 2 * e + 1] * bfhi(hh[e]) * bfhi(gc[e]); } } }
        const u32x4 gbv = *(const u32x4*)(pr + 1024 + c8); u32x4 o;
#pragma unroll
        for (int e = 0; e < 4; ++e) o[e] = pk2(y[2 * e] * bflo(gbv[e]), y[2 * e + 1] * bfhi(gbv[e]));
        *(u32x4*)(Y + (size_t)m * OD_Y + 1024 + c8) = o; }
}

#ifdef EMU
static float* emu_dbg_sc = nullptr;
#endif
constexpr int NU32 = SEQ / 64, UBK = (NU32 < 8) ? NU32 : 8;
__device__ __forceinline__ unsigned sortable(float f) { f = f + 0.0f;     unsigned u; memcpy(&u, &f, 4); return u ^ ((u >> 31) ? 0xffffffffu : 0x80000000u); }
__device__ __forceinline__ void dsa_sel_loadq(const Ctx& C, int b, int pg, bf16x8 (&qf)[4][2], f32x4 (&wq)[4]) {
    const int lane = C.lane, g = lane >> 4, lr = lane & 15, rb0 = 4 * (C.wave >> 2); const size_t mb = (size_t)b * SEQ;
    const bf16_t* QL = WSP(bf16_t, WS_BIG) + (size_t)M * OD_INP; const float* WI = WSP(float, WS_WI);
#pragma unroll
    for (int j = 0; j < 4; ++j) { const size_t mr = mb + 16 * pg + 2 * (rb0 + j); const bf16_t* qr = QL + (mr + (lr >> 3)) * DQN + 1024 + (lr & 7) * 64 + 8 * g;
        qf[j][0] = *(const bf16x8*)qr; qf[j][1] = *(const bf16x8*)(qr + 32);
        wq[j] = *(const f32x4*)(WI + (mr + (g >> 1)) * 8 + 4 * (g & 1)); }
}
__device__ __forceinline__ void dsa_sel_item(const Ctx& C, int b, int pp, LAS float* SC, int tlast, bf16x8 (&qf)[4][2], f32x4 (&wq)[4], bool has_next, int nb, int npg) {
    const int lane = C.lane, g = lane >> 4, lr = lane & 15; const int tA = 2 * pp, tB = tA + 1; const size_t mb = (size_t)b * SEQ, m0 = mb + tA;
    const bf16_t* KI = WSP(bf16_t, WS_KI);
    unsigned long long* MASK = WSP(unsigned long long, WS_MASK);
    { const int w = C.wave, cb = w & 3, rb0 = 4 * (w >> 2);
      WAIT_VM(0);
#pragma unroll
      for (int j = 0; j < 4; ++j) { LAUNDER_V(qf[j][0]); LAUNDER_V(qf[j][1]); LAUNDER_V(wq[j]); }
      RPT(71) { const int n64 = (tlast >> 6) + 1; bf16x8 kq[2][2];
        const bf16_t* kip = KI + (mb + cb * 16 + lr) * 64 + 8 * g;
        kq[0][0] = *(const bf16x8*)kip; kq[0][1] = *(const bf16x8*)(kip + 32); SCHED_FENCE();
        { const unsigned o1 = (unsigned)((n64 > 1 ? 1 : 0) * 64 * 64); kq[1][0] = *(const bf16x8*)(kip + o1); kq[1][1] = *(const bf16x8*)(kip + o1 + 32); } SCHED_FENCE();
        LAS float* scw = SC - w * (2 * SEQ) + (2 * (rb0 + (g & 1)) + (g >> 1)) * SEQ + cb * 16 + lr;
#define SEL_STEP(KT_, SG) do { \
            f32x4 acc[4]; float ps[4]; \
            _Pragma("unroll") for (int j = 0; j < 4; ++j) { acc[j] = mfma16(qf[j][0], kq[SG][0], (f32x4){0.f, 0.f, 0.f, 0.f}); acc[j] = mfma16(qf[j][1], kq[SG][1], acc[j]); } \
            SCHED_FENCE(); __asm__ volatile("" ::: "memory");                                \
            { const unsigned o2 = (unsigned)((((KT_) + 2 < n64) ? (KT_) + 2 : n64 - 1) * 64 * 64); kq[SG][0] = *(const bf16x8*)(kip + o2); kq[SG][1] = *(const bf16x8*)(kip + o2 + 32); } \
            __asm__ volatile("" ::: "memory"); SCHED_FENCE(); \
            _Pragma("unroll") for (int j = 0; j < 4; ++j) { ps[j] = wq[j][0] * fmaxf(acc[j][0], 0.f); \
                _Pragma("unroll") for (int i = 1; i < 4; ++i) ps[j] = fmaf(wq[j][i], fmaxf(acc[j][i], 0.f), ps[j]); } \
            xr16_swap2(ps[0], ps[1]); xr16_swap2(ps[2], ps[3]);                              \
            scw[(KT_) * 64] = ps[0] + ps[1]; scw[4 * SEQ + (KT_) * 64] = ps[2] + ps[3]; } while (0)
        int kt = 0;
        for (; kt + 1 < n64; kt += 2) { SEL_STEP(kt, 0); SEL_STEP(kt + 1, 1); }
        if (kt < n64) SEL_STEP(kt, 0);
#undef SEL_STEP
        WAIT_VM(0); LAUNDER_V(kq[0][0]); LAUNDER_V(kq[0][1]); LAUNDER_V(kq[1][0]); LAUNDER_V(kq[1][1]);
        WAIT_LGKM(0); SYNC(); }
      dsa_sel_loadq(C, nb, npg, qf, wq); }
    WAIT_LGKM(0);
#ifdef EMU
    if (emu_dbg_sc && b == 0) for (int j = lane; j < SEQ; j += 64) { emu_dbg_sc[(size_t)tA * SEQ + j] = SC[j]; emu_dbg_sc[(size_t)tB * SEQ + j] = SC[SEQ + j]; }
#endif
    unsigned u0[NU32], u1[NU32];
#pragma unroll
    for (int i = 0; i < NU32; ++i) { const int j = lane + 64 * i; u0[i] = (j <= tA) ? sortable(SC[j]) : 0u; u1[i] = (j <= tB) ? sortable(SC[SEQ + j]) : 0u; }
    unsigned lo0, hi0, lo1, hi1; bool sep0, sep1;
    RPT(72) { lo0 = 1u; hi0 = 0xffffffffu; lo1 = 1u; hi1 = 0xffffffffu; sep0 = (tA + 1 <= TOPK); sep1 = (tB + 1 <= TOPK);
    bool run0 = !sep0, run1 = !sep1;
    while (run0 || run1) {
        const unsigned mid0 = lo0 + ((hi0 - lo0) >> 1), mid1 = lo1 + ((hi1 - lo1) >> 1); int c0 = 0, c1 = 0;
#pragma unroll
        for (int blk = 0; blk < NU32 / UBK; ++blk) if (blk * UBK <= (tB >> 6)) {
#pragma unroll
            for (int i = blk * UBK; i < blk * UBK + UBK; ++i) { c0 += popc64(ballot64(u0[i] >= mid0)); c1 += popc64(ballot64(u1[i] >= mid1)); } }
        if (run0) { if (c0 == TOPK) { lo0 = mid0; sep0 = true; run0 = false; } else { if (c0 > TOPK) lo0 = mid0; else hi0 = mid0; if (hi0 - lo0 <= 1u) run0 = false; } }
        if (run1) { if (c1 == TOPK) { lo1 = mid1; sep1 = true; run1 = false; } else { if (c1 > TOPK) lo1 = mid1; else hi1 = mid1; if (hi1 - lo1 <= 1u) run1 = false; } }
    } }
    RPT(73)
#pragma unroll
    for (int tok = 0; tok < 2; ++tok) { const int t = tA + tok; const unsigned thr = tok ? lo1 : lo0; const bool sep = tok ? sep1 : sep0; int jcut = SEQ;
        if (!sep) { int cg = 0, ce = 0;
#pragma unroll
            for (int i = 0; i < NU32; ++i) { const unsigned uv = tok ? u1[i] : u0[i]; cg += (uv > thr) ? 1 : 0; ce += (uv == thr) ? 1 : 0; }
            cg = wave_isum(cg); ce = wave_isum(ce); const int need = TOPK - cg;
            if (ce > need) { int J = 0;
                for (int bit = 12; bit >= 0; --bit) { const int cand = J | (1 << bit); int c = 0;
#pragma unroll
                    for (int i = 0; i < NU32; ++i) { const unsigned uv = tok ? u1[i] : u0[i]; c += (uv == thr && (lane + 64 * i) < cand) ? 1 : 0; }
                    if (wave_isum(c) < need) J = cand; }
                jcut = J; } }
        unsigned long long myw = 0ull;
        if (sep) {
#pragma unroll
            for (int blk = 0; blk < NU32 / UBK; ++blk) if (blk * UBK <= (tB >> 6)) {
#pragma unroll
                for (int i = blk * UBK; i < blk * UBK + UBK; ++i) { const unsigned uv = tok ? u1[i] : u0[i]; const unsigned long long bits = ballot64(uv >= thr); setlane64(myw, bits, i, lane); } }
        } else {
#pragma unroll
            for (int i = 0; i < NU32; ++i) { const int j = lane + 64 * i; const unsigned uv = tok ? u1[i] : u0[i];
                const bool sel = (j <= t) && (uv > thr || (uv == thr && j <= jcut)); const unsigned long long bits = ballot64(sel); setlane64(myw, bits, i, lane); } }
        if (lane < NU32) MASK[(m0 + tok) * NU32 + lane] = myw;
    }
}
__device__ __forceinline__ void dsa_select_phase(const Ctx& C) {
    LAS float* SC = (LAS float*)(C.lds + C.wave * (2 * SEQ * 4));
    constexpr int NUN = NB * (SEQ / 16);
    bf16x8 qf[4][2]; f32x4 wq[4]; bool have = false;
    for (int k = 0;; ++k) { const int idx = k * C.G + ((k & 1) ? (C.G - 1 - C.bid) : C.bid); if (idx >= NUN) { if (k * C.G >= NUN) break; else continue; }
        const int pg = idx / NB, b = idx % NB; if (!have) dsa_sel_loadq(C, b, pg, qf, wq);
        const int k2 = k + 1, idx2 = k2 * C.G + ((k2 & 1) ? (C.G - 1 - C.bid) : C.bid); const bool hn = idx2 < NUN;
        dsa_sel_item(C, b, pg * 8 + C.wave, SC, pg * 16 + 15, qf, wq, hn, hn ? idx2 % NB : b, hn ? idx2 / NB : pg); have = hn; SYNC(); }
}

constexpr int DA_KLD = 136, DA_VLD = 72, DA_KBYTES = 64 * DA_KLD * 2, DA_VBYTES = 128 * DA_VLD * 2, DA_BUF = DA_KBYTES + DA_VBYTES;
__device__ __forceinline__ void dsa_attn_unit(const Ctx& C, int b, int qt) {
    const int tid = C.tid, lane = C.lane, w = C.wave, g = lane >> 4, lr = lane & 15; const size_t mb = (size_t)b * SEQ; const int t0 = qt * 32; const size_t m0 = mb + t0;
    const bf16_t* QL = WSP(bf16_t, WS_BIG) + (size_t)M * OD_INP; const bf16_t* CKV = WSP(bf16_t, WS_CKV); const bf16_t* CKVT = WSP(bf16_t, WS_CKVT);
    const unsigned long long* MASK = WSP(unsigned long long, WS_MASK); bf16_t* Y = WSP(bf16_t, WS_Y);
    bf16x8 ql[2][4];
#pragma unroll
    for (int rt = 0; rt < 2; ++rt) { const size_t mrow_ = m0 + 4 * w + 2 * rt + (lr >> 3); const bf16_t* qr = QL + mrow_ * DQN + (lr & 7) * 128;
#pragma unroll
        for (int ks = 0; ks < 4; ++ks) ql[rt][ks] = *(const bf16x8*)(qr + 32 * ks + 8 * g); }
    f32x4 oacc[2][8], minit[2]; float lrun[2];
#pragma unroll
    for (int rt = 0; rt < 2; ++rt) { minit[rt] = (f32x4){0.f, 0.f, 0.f, 0.f}; lrun[rt] = 0.f;
#pragma unroll
        for (int nv = 0; nv < 8; ++nv) oacc[rt][nv] = (f32x4){0.f, 0.f, 0.f, 0.f}; }
    const int nk = (t0 + 31) / 64 + 1;
    const int kr = tid >> 3, kc = (tid & 7) * 16, vr = tid >> 2, vc = (tid & 3) * 16;
    u32x4 sk[2], sv[2];
    const bf16_t* kbase = CKV + mb * 128; const bf16_t* vbase = CKVT + (size_t)b * 128 * SEQ; const unsigned koff = (unsigned)(kr * 128 + kc), voff = (unsigned)(vr * SEQ + vc);
    const unsigned long long* mbase = MASK + m0 * NU32;
#define DA_LOAD(kt) do { const bf16_t* kp = kbase + ((unsigned)((kt) * 64 * 128) + koff); sk[0] = *(const u32x4*)kp; sk[1] = *(const u32x4*)(kp + 8); \
        const bf16_t* vp = vbase + ((unsigned)((kt) * 64) + voff); sv[0] = *(const u32x4*)vp; sv[1] = *(const u32x4*)(vp + 8); } while (0)
#define DA_STORE(buf) do { LAS bf16_t* kd = (LAS bf16_t*)(C.lds + (buf) * DA_BUF) + kr * DA_KLD + kc; *(LAS u32x4*)kd = sk[0]; *(LAS u32x4*)(kd + 8) = sk[1]; \
        LAS bf16_t* vd = (LAS bf16_t*)(C.lds + (buf) * DA_BUF + DA_KBYTES) + vr * DA_VLD + vc; *(LAS u32x4*)vd = sv[0]; *(LAS u32x4*)(vd + 8) = sv[1]; } while (0)
#define DA_KB(i) ((LAS bf16_t*)(C.lds + (i) * DA_KBYTES))
#define DA_VB(j) ((LAS bf16_t*)(C.lds + 2 * DA_KBYTES + (j) * DA_VBYTES))
#undef DA_STORE
#define DA_STORE(kb, vb) do { LAS bf16_t* kd = DA_KB(kb) + kr * DA_KLD + kc; *(LAS u32x4*)kd = sk[0]; *(LAS u32x4*)(kd + 8) = sk[1]; \
        LAS bf16_t* vd = DA_VB(vb) + vr * DA_VLD + vc; *(LAS u32x4*)vd = sv[0]; *(LAS u32x4*)(vd + 8) = sv[1]; } while (0)
    const bool grpB = (w >= 4);
    f32x4 sacc[2][4]; bf16x8 pf[2][2];
#define DA_S(KT) do { _Pragma("unroll") for (int nt = 0; nt < 4; ++nt) { \
        _Pragma("unroll") for (int ks = 0; ks < 4; ++ks) { const bf16x8 kf = *(const LAS bf16x8*)((KT) + (nt * 16 + lr) * DA_KLD + 32 * ks + 8 * g); \
            sacc[0][nt] = mfma16(kf, ql[0][ks], ks ? sacc[0][nt] : minit[0]); sacc[1][nt] = mfma16(kf, ql[1][ks], ks ? sacc[1][nt] : minit[1]); } } } while (0)
#define DA_SM(T, FIRST) do { int lx_ = lane; LAUNDER_V(lx_); const LAS unsigned long long* mwp = MW + ((lx_ >> 3) & 1) * NU32 + (T); float mxr[2]; \
    _Pragma("unroll") for (int rt = 0; rt < 2; ++rt) { float mx = -1e30f; \
        _Pragma("unroll") for (int nt = 0; nt < 4; ++nt) _Pragma("unroll") for (int i = 0; i < 4; ++i) mx = fmaxf(mx, sacc[rt][nt][i]); \
        mxr[rt] = xr32_max(xr16_max(mx)); } \
    if ((FIRST) || ballot64(fmaxf(mxr[0], mxr[1]) > 8.f) != 0ull) { \
        _Pragma("unroll") for (int rt = 0; rt < 2; ++rt) { const float d = (FIRST) ? mxr[rt] : fmaxf(mxr[rt], 0.f); const float al = (FIRST) ? 1.f : fexp2(-d); lrun[rt] *= al; \
            _Pragma("unroll") for (int nv = 0; nv < 8; ++nv) oacc[rt][nv] *= al; \
            _Pragma("unroll") for (int nt = 0; nt < 4; ++nt) sacc[rt][nt] = sacc[rt][nt] - d; \
            const float nr = minit[rt][0] - d; minit[rt] = (f32x4){nr, nr, nr, nr}; } } \
    _Pragma("unroll") for (int rt = 0; rt < 2; ++rt) { const unsigned long long mkv = mwp[rt * 2 * NU32]; float ps = 0.f; unsigned pw[8]; \
        _Pragma("unroll") for (int nt = 0; nt < 4; ++nt) { float pv[4]; const unsigned nib = (unsigned)(mkv >> (nt * 16 + 4 * g)); \
            _Pragma("unroll") for (int i = 0; i < 4; ++i) { pv[i] = __builtin_bit_cast(float, __builtin_bit_cast(int, fexp2(sacc[rt][nt][i])) & bfe_i1(nib, i)); ps += pv[i]; } \
            pw[2 * nt] = pk2(pv[0], pv[1]); pw[2 * nt + 1] = pk2(pv[2], pv[3]); } \
        lrun[rt] += ps; \
        pf[rt][0] = __builtin_bit_cast(bf16x8, (u32x4){pw[0], pw[1], pw[2], pw[3]}); pf[rt][1] = __builtin_bit_cast(bf16x8, (u32x4){pw[4], pw[5], pw[6], pw[7]}); } \
        } while (0)
#define DA_PV(VT) do { _Pragma("unroll") for (int nv = 0; nv < 8; ++nv) _Pragma("unroll") for (int s2 = 0; s2 < 2; ++s2) { const LAS bf16_t* vp = (VT) + (nv * 16 + lr) * DA_VLD + s2 * 32 + 4 * g; \
        const u32x2 lo = *(const LAS u32x2*)vp, hi = *(const LAS u32x2*)(vp + 16); const bf16x8 vf = __builtin_bit_cast(bf16x8, (u32x4){lo.x, lo.y, hi.x, hi.y}); \
        oacc[0][nv] = mfma16(vf, pf[0][s2], oacc[0][nv]); oacc[1][nv] = mfma16(vf, pf[1][s2], oacc[1][nv]); } } while (0)
    DA_LOAD(0); DA_STORE(0, 0);
    LAS unsigned long long* MW = (LAS unsigned long long*)(C.lds + 2 * DA_KBYTES + 3 * DA_VBYTES) + w * (4 * NU32);
    for (int i = lane; i < 4 * NU32; i += 64) MW[i] = mbase[(unsigned)(4 * w * NU32 + i)];
    WAIT_VM(0);
#pragma unroll
    for (int rt = 0; rt < 2; ++rt)
#pragma unroll
        for (int ks = 0; ks < 4; ++ks) LAUNDER_V(ql[rt][ks]);
    SYNC();
    if (!grpB) {
        int vbs = 0;
        for (int st = 0; st <= nk; ++st) {
            if (st + 1 < nk) DA_LOAD(st + 1);
            if (st < nk) { DA_S(DA_KB(st & 1)); DA_SM(st, st == 0); DA_PV(DA_VB(vbs)); }
            const int vbn = (vbs == 2) ? 0 : vbs + 1;
            if (st + 1 < nk) DA_STORE((st + 1) & 1, vbn);
            vbs = vbn;
            SYNC();
        }
    } else {
        int vbs = 0, vbp = 2;
        for (int st = 0; st <= nk; ++st) {
            if (st + 1 < nk) DA_LOAD(st + 1);
            if (st >= 1) DA_PV(DA_VB(vbp));
            if (st < nk) { DA_S(DA_KB(st & 1)); DA_SM(st, st == 0); }
            const int vbn = (vbs == 2) ? 0 : vbs + 1;
            if (st + 1 < nk) DA_STORE((st + 1) & 1, vbn);
            vbp = vbs; vbs = vbn;
            SYNC();
        }
    }
#undef DA_S
#undef DA_SM
#undef DA_PV
#undef DA_KB
#undef DA_VB
#pragma unroll
    for (int rt = 0; rt < 2; ++rt) { float l = xr32_sum(xr16_sum(lrun[rt])); const float inv = 1.f / l;
        int lrb = lr; LAUNDER_V(lrb);
        bf16_t* yr = Y + (m0 + 4 * w + 2 * rt + (lrb >> 3)) * OD_Y + (lrb & 7) * 128 + 4 * g;
#pragma unroll
        for (int nv = 0; nv < 8; ++nv) { u32x2 o; o.x = pk2(oacc[rt][nv][0] * inv, oacc[rt][nv][1] * inv); o.y = pk2(oacc[rt][nv][2] * inv, oacc[rt][nv][3] * inv); *(u32x2*)(yr + nv * 16) = o; } }
#undef DA_LOAD
#undef DA_STORE
}
__device__ __forceinline__ void dsa_attn_phase(const Ctx& C) {
    constexpr int NQT = SEQ / 32, NUN = NB * NQT;
    for (int k = 0;; ++k) { const int idx = k * C.G + ((k & 1) ? (C.G - 1 - C.bid) : C.bid); if (idx >= NUN) { if (k * C.G >= NUN) break; else continue; }
        const int qt = idx / NB, b = idx % NB; dsa_attn_unit(C, b, qt); LSYNC(); }
}

constexpr int XA_Q = (SEQ >= 512) ? 512 : SEQ, XA_KLD = 136, XA_VLD = 264;
__device__ __forceinline__ void xattn_phase(const Ctx& C, int l) {
    const int tid = C.tid, lane = C.lane, w = C.wave, g = lane >> 4, lr = lane & 15;
    const bf16_t* Q = WSP(bf16_t, WS_BIG); bf16_t* AO = WSP(bf16_t, WS_BIG) + (size_t)M * 512; const bf16_t* KB = DOP(DO_KB) + l * 512; const bf16_t* VT = DOP(DO_VT) + (size_t)l * 512 * MM; constexpr int KLD = DEPTH * 512;
    LAS bf16_t* KL = (LAS bf16_t*)C.lds; LAS bf16_t* VL = KL + 256 * XA_KLD;
    constexpr int NQR = SEQ / XA_Q, NUN = NB * 4 * NQR;
    for (int u = C.bid; u < NUN; u += C.G) { const int qr = u % NQR, bh = u / NQR, h = bh & 3, b = bh >> 2;
        { const int j = tid >> 1, hf = (tid & 1) * 64; const bf16_t* kp = KB + ((size_t)b * 256 + j) * KLD + h * 128 + hf; LAS bf16_t* kd = KL + j * XA_KLD + hf;
#pragma unroll
          for (int q = 0; q < 8; ++q) *(LAS u32x4*)(kd + 8 * q) = *(const u32x4*)(kp + 8 * q);
          const int d = tid >> 2, sg = (tid & 3) * 64; const bf16_t* vp = VT + ((size_t)h * 128 + d) * MM + (size_t)b * 256 + sg; LAS bf16_t* vd = VL + d * XA_VLD + sg;
#pragma unroll
          for (int q = 0; q < 8; ++q) *(LAS u32x4*)(vd + 8 * q) = *(const u32x4*)(vp + 8 * q); }
        LSYNC();
        for (int it = 0; it < XA_Q / 256; ++it) {
            const size_t mbase = (size_t)b * SEQ + (size_t)qr * XA_Q + it * 256 + w * 32;
            bf16x8 ql[2][4];
#pragma unroll
            for (int rt = 0; rt < 2; ++rt) { const bf16_t* qp = Q + (mbase + rt * 16 + lr) * 512 + h * 128;
#pragma unroll
                for (int ks = 0; ks < 4; ++ks) ql[rt][ks] = *(const bf16x8*)(qp + 32 * ks + 8 * g); }
            f32x4 oacc[2][8], minit[2]; float lrun[2];
#pragma unroll
            for (int rt = 0; rt < 2; ++rt) { minit[rt] = (f32x4){0.f, 0.f, 0.f, 0.f}; lrun[rt] = 0.f;
#pragma unroll
                for (int nv = 0; nv < 8; ++nv) oacc[rt][nv] = (f32x4){0.f, 0.f, 0.f, 0.f}; }
#pragma unroll 1
            for (int kc = 0; kc < 4; ++kc) {
                f32x4 sacc[2][4];
#pragma unroll
                for (int nt = 0; nt < 4; ++nt) {
#pragma unroll
                    for (int ks = 0; ks < 4; ++ks) { const bf16x8 kf = *(const LAS bf16x8*)(KL + (kc * 64 + nt * 16 + lr) * XA_KLD + 32 * ks + 8 * g);
                        sacc[0][nt] = mfma16(kf, ql[0][ks], ks ? sacc[0][nt] : minit[0]); sacc[1][nt] = mfma16(kf, ql[1][ks], ks ? sacc[1][nt] : minit[1]); } }
                bf16x8 pf[2][2]; float mxr[2];
#pragma unroll
                for (int rt = 0; rt < 2; ++rt) { float mx = -1e30f;
#pragma unroll
                    for (int nt = 0; nt < 4; ++nt)
#pragma unroll
                        for (int i = 0; i < 4; ++i) mx = fmaxf(mx, sacc[rt][nt][i]);
                    mxr[rt] = xr32_max(xr16_max(mx)); }
                if (kc == 0 || ballot64(fmaxf(mxr[0], mxr[1]) > 8.f) != 0ull) {
#pragma unroll
                    for (int rt = 0; rt < 2; ++rt) { const float d = (kc == 0) ? mxr[rt] : fmaxf(mxr[rt], 0.f); const float al = (kc == 0) ? 1.f : fexp2(-d); lrun[rt] *= al;
#pragma unroll
                        for (int nv = 0; nv < 8; ++nv) oacc[rt][nv] *= al;
#pragma unroll
                        for (int nt = 0; nt < 4; ++nt) sacc[rt][nt] = sacc[rt][nt] - d;
                        const float nr = minit[rt][0] - d; minit[rt] = (f32x4){nr, nr, nr, nr}; } }
#pragma unroll
                for (int rt = 0; rt < 2; ++rt) { float ps = 0.f; unsigned pw[8];
#pragma unroll
                    for (int nt = 0; nt < 4; ++nt) { float pv[4];
#pragma unroll
                        for (int i = 0; i < 4; ++i) { pv[i] = fexp2(sacc[rt][nt][i]); ps += pv[i]; }
                        pw[2 * nt] = pk2(pv[0], pv[1]); pw[2 * nt + 1] = pk2(pv[2], pv[3]); }
                    lrun[rt] += ps;
                    pf[rt][0] = __builtin_bit_cast(bf16x8, (u32x4){pw[0], pw[1], pw[2], pw[3]}); pf[rt][1] = __builtin_bit_cast(bf16x8, (u32x4){pw[4], pw[5], pw[6], pw[7]});
                }
#pragma unroll
                for (int nv = 0; nv < 8; ++nv)
#pragma unroll
                    for (int s2 = 0; s2 < 2; ++s2) { const LAS bf16_t* vp = VL + (nv * 16 + lr) * XA_VLD + kc * 64 + s2 * 32 + 4 * g;
                        const u32x2 lo = *(const LAS u32x2*)vp, hi = *(const LAS u32x2*)(vp + 16);
                        const bf16x8 vf = __builtin_bit_cast(bf16x8, (u32x4){lo.x, lo.y, hi.x, hi.y});
                        oacc[0][nv] = mfma16(vf, pf[0][s2], oacc[0][nv]); oacc[1][nv] = mfma16(vf, pf[1][s2], oacc[1][nv]); }
            }
#pragma unroll
            for (int rt = 0; rt < 2; ++rt) { float l = xr32_sum(xr16_sum(lrun[rt])); const float inv = frcp(l);
                bf16_t* orow = AO + (mbase + rt * 16 + lr) * 512 + h * 128 + 4 * g;
#pragma unroll
                for (int nv = 0; nv < 8; ++nv) { u32x2 o; o.x = pk2(oacc[rt][nv][0] * inv, oacc[rt][nv][1] * inv); o.y = pk2(oacc[rt][nv][2] * inv, oacc[rt][nv][3] * inv); *(u32x2*)(orow + nv * 16) = o; } }
        }
        LSYNC();
    }
}

#define GEMM_CALL(EPI, Aptr, Bptr, Mv, Nv, Kv, Optr, ldcv, rsv) do { pg8::Gemm gg_{(const bf16_t*)(Aptr), (const bf16_t*)(Bptr), (Mv), (Nv), (Kv)}; pg8::StaticOrder so_; so_.init((Mv), (Nv), C.G, C.bid); \
    pg8::EPI ee_{(bf16_t*)(Optr), (ldcv), (const float*)(rsv)}; pg8::gemm_phase<pg8::EPI>(C.lds, gg_, so_, ee_, C.tid); } while (0)

#define FUSED_CALL(Aptr, Bptr, Kv, EPOCH, SCALE, Gptr, OUTF) do { pg8::Gemm gg_{(const bf16_t*)(Aptr), (const bf16_t*)(Bptr), M, D, (Kv)}; pg8::StaticOrder so_; so_.init(M, D, C.G, C.bid); so_.imax = 1; \
    pg8::EpiFused ee_{XN_, (Gptr), (SCALE), WSP(float, WS_RSTD), (OUTF), WSP(float, WS_X1), WSP(float, WS_X2), (unsigned*)(C.ws + WS_CTL + 16384), 16u * ((unsigned)(EPOCH) + 1u), (unsigned*)(C.ws + WS_CTL + 15360)}; \
    const int ncall_ = (so_.nwg + C.G - 1) / C.G; _Pragma("unroll 1") for (int cc_ = 0; cc_ < ncall_; ++cc_) { so_.i0 = cc_; pg8::gemm_phase<pg8::EpiFused>(C.lds, gg_, so_, ee_, C.tid); LSYNC(); } } while (0)

__global__ void __launch_bounds__(NTHREADS, 2) fwd(Args a) {
    DYN_LDS(lds);
#define MKCTX() Ctx C; { int t_ = threadIdx.x; LAUNDER_V(t_); unsigned long long wi_ = (unsigned long long)a.ws, xi_ = (unsigned long long)a.out; LAUNDER_S(wi_); LAUNDER_S(xi_); unsigned char* w_ = (unsigned char*)(GAS unsigned char*)wi_; float* x_ = (float*)(GAS float*)xi_; int g_ = gridDim.x, b_ = blockIdx.x; LAUNDER_S(g_); LAUNDER_S(b_); LAS unsigned char* l_ = lds; LAUNDER_S(l_); \
    C.lds = l_; C.in.lds = l_; C.X = x_; C.ws = w_; C.tid = t_; C.lane = t_ & 63; C.wave = rfl(t_ >> 6); C.G = g_; C.bid = b_; }
    const int tid0 = threadIdx.x;
    volatile LAS unsigned* misc = (volatile LAS unsigned*)(lds + LDS_MISC);
    if (tid0 < 64) misc[tid0] = 0u;
    if (tid0 < N_IN) { const unsigned long long pv = (unsigned long long)a.in[tid0]; LAS unsigned* t = (LAS unsigned*)(lds + LDS_TAB); t[2 * tid0] = (unsigned)pv; t[2 * tid0 + 1] = (unsigned)(pv >> 32); }
    SYNC();
    XcdBarrier bar = xcd_barrier_post((unsigned*)(a.ws + WS_CTL), misc + 8);
    const int lo = a.ph_lo, hi = a.ph_hi;
    for (int j = 0; j < 2 * DEPTH; ++j) {
        const int l = j >> 1, s = j & 1, base = l * SLOTS, li = l >> 1; const bool even = !(l & 1);
#ifndef PHMASK
#define PHMASK 0x3ffff
#endif
#define IN(sl) (((PHMASK >> ((sl) > 14 ? (sl) - 14 : (sl))) & 1) && lo <= base + (sl) && base + (sl) < hi)
#define SEAM(sl) do { if (base + (sl) + 1 < hi) { XcdBarrier b2_ = bar; b2_.bar = (unsigned*)(C.ws + WS_CTL); LAUNDER_S(b2_.x); xcd_barrier(b2_, C.tid); } } while (0)
#define XN_ WSP(bf16_t, WS_XN)
#define HO_ ((bf16_t*)C.X)
#define BIG_ WSP(bf16_t, WS_BIG)
#define NG_ (C.in[I_NORMG] + (size_t)l * 8 * D)
        if (s == 0 && IN(0)) { MKCTX(); RPT(0) conv_phase(C, l, ((l & 1) && C.G > NB * 12) ? 2 : 3, C.bid, C.G); SEAM(0); }
        const int f0 = s ? 15 : 1;
        if (IN(f0)) { MKCTX(); RPT(1) GEMM_CALL(EpiSwiGLU, XN_, WSP(bf16_t, WS_WGU) + (size_t)s * NGU * D, M, NGU, D, BIG_, DFF, nullptr); SEAM(f0); }
        if (IN(f0 + 1)) { MKCTX(); const bool last = (s == 1 && l == DEPTH - 1); const float* ng = NG_;
            FUSED_CALL(BIG_, WSP(bf16_t, WS_WDN) + (size_t)s * D * DFF, DFF, l * 4 + (s ? 3 : 0), 0.5f, ng + (s ? 7 : 1) * D, last ? C.X : (float*)nullptr); SEAM(f0 + 1); }
        if (s == 0) {
            if (IN(4)) { MKCTX(); RPT(4) GEMM_CALL(EpiBf16, XN_, WSP(bf16_t, WS_WIN), M, even ? EV_IN : OD_INP, D, BIG_, even ? EV_IN : OD_INP, nullptr); SEAM(4); }
            if (IN(5)) {
                if (even) { const int NRW = NB * 8, NU = NRW + NB * 4;
                    { MKCTX(); RPT(5) for (int u = C.bid; u < NRW; u += C.G) { rwkv_unit2(C, u, li); SYNC(); } }
                    { MKCTX(); RPT(55) for (int u = C.bid + ((NRW + C.G - 1 - C.bid) / C.G) * C.G; u < NU; u += C.G) { ret_unit(C, u - NRW, li); SYNC(); } }
                    { MKCTX(); if (l + 1 < DEPTH && C.G > NU && C.bid >= NU) conv_phase(C, l + 1, 1, C.bid - NU, C.G - NU); } }
                else { MKCTX(); RPT(56) dsa_prep_phase(C, li); }
                { MKCTX(); SEAM(5); } }
            if (!even && IN(6)) { MKCTX(); RPT(6) GEMM_CALL(EpiBf16, WSP(bf16_t, WS_CQN), WSP(bf16_t, WS_WDQ), M, DQN, 256, BIG_ + (size_t)M * OD_INP, DQN, nullptr); SEAM(6); }
            if (!even && IN(7)) { MKCTX(); RPT(7) dsa_select_phase(C); SEAM(7); }
            if (!even && IN(8)) { MKCTX(); RPT(8) dsa_attn_phase(C); SEAM(8); }
            if (IN(9)) { MKCTX(); const float* ng = NG_; FUSED_CALL(WSP(bf16_t, WS_Y), WSP(bf16_t, WS_WOUT), even ? D : OD_Y, l * 4 + 1, 1.f, ng + 3 * D, (float*)nullptr); SEAM(9); }
            if (IN(11)) { MKCTX(); RPT(11)
#pragma unroll 1
                for (int k = 0; k < (l == 0 ? 3 : 1); ++k) {
                    const bf16_t* A_ = k == 0 ? XN_ : (k == 1 ? WSP(bf16_t, WS_MEMN) : DOP(DO_WV));
                    const bf16_t* B_ = k == 0 ? WSP(bf16_t, WS_WQ) : (k == 1 ? DOP(DO_WK) : WSP(bf16_t, WS_MEMN));
                    bf16_t* O_ = k == 0 ? BIG_ : (k == 1 ? DOP(DO_KB) : DOP(DO_VT));
                    const int M_ = k == 0 ? M : (k == 1 ? MM : DEPTH * 512), N_ = k == 0 ? 512 : (k == 1 ? DEPTH * 512 : MM);
                    GEMM_CALL(EpiBf16, A_, B_, M_, N_, D, O_, N_, nullptr); }
                SEAM(11); }
            if (IN(12)) { MKCTX(); RPT(12) xattn_phase(C, l); SEAM(12); }
            if (IN(13)) { MKCTX(); const float* ng = NG_; FUSED_CALL(BIG_ + (size_t)M * 512, WSP(bf16_t, WS_WO), 512, l * 4 + 2, 1.f, ng + 5 * D, (float*)nullptr); SEAM(13); }
        }
#undef IN
#undef SEAM
    }
}

static bool slot_used(int ph) { const int l = ph / SLOTS, sl = ph % SLOTS; if ((sl == 6 || sl == 7 || sl == 8) && !(l & 1)) return false; if (sl == 3 || sl == 10 || sl == 14 || sl == 17) return false;     return true; }
extern "C" void kernel_launch(void* const* d_in, const int* in_sizes, int n_in, void* d_out, int out_size, void* d_ws, size_t ws_size, hipStream_t stream) {
    (void)in_sizes; (void)out_size;
    if (n_in != N_IN || ws_size < WS_END) { fprintf(stderr, "kernel_launch: unexpected n_in %d or ws %zu < %zu\n", n_in, ws_size, (size_t)WS_END); return; }
    Args a; memset(&a, 0, sizeof(a));
    for (int i = 0; i < N_IN; ++i) a.in[i] = (const float*)d_in[i];
    a.out = (float*)d_out; a.ws = (unsigned char*)d_ws;
#ifdef EMU
    const int grid = emu_grid();
    memset((char*)d_ws + WS_CTL, 0, CTL_BYTES);
    if (emu_one_launch()) { a.ph_lo = emu_ph_lo(); a.ph_hi = emu_ph_hi(); emu_launch([=]() { fwd(a); }, grid, NTHREADS, LDS_BYTES, true); }
    else for (int ph = emu_ph_lo(); ph < emu_ph_hi(); ++ph) { if (!slot_used(ph)) continue; a.ph_lo = ph; a.ph_hi = ph + 1; fprintf(stderr, "[emu] phase %d (layer %d slot %d)\n", ph, ph / SLOTS, ph % SLOTS); emu_launch([=]() { fwd(a); }, grid, NTHREADS, LDS_BYTES, getenv("EMU_SERIAL") != nullptr); }
#else
    static int grid = 0;
    if (grid == 0) {
        int dev = 0, cus = 0;
        if (hipGetDevice(&dev) != hipSuccess || hipDeviceGetAttribute(&cus, hipDeviceAttributeMultiprocessorCount, dev) != hipSuccess) { grid = -1; return; }
        if (hipFuncSetAttribute((const void*)fwd, hipFuncAttributeMaxDynamicSharedMemorySize, LDS_BYTES) != hipSuccess) { fprintf(stderr, "kernel_launch: hipFuncSetAttribute failed\n"); grid = -1; return; }
        int per_cu = 0; (void)hipOccupancyMaxActiveBlocksPerMultiprocessor(&per_cu, (const void*)fwd, NTHREADS, LDS_BYTES); (void)hipGetLastError();
        grid = cus;
    }
    if (grid < 0) return;
    (void)hipMemsetAsync((char*)d_ws + WS_CTL, 0, CTL_BYTES, stream);
    if (MK_N_LAUNCHES == 1) { a.ph_lo = 0; a.ph_hi = NPH; hipLaunchKernelGGL(fwd, dim3(grid), dim3(NTHREADS), LDS_BYTES, stream, a); }
    else for (int ph = 0; ph < NPH; ++ph) { if (!slot_used(ph)) continue; a.ph_lo = ph; a.ph_hi = ph + 1; hipLaunchKernelGGL(fwd, dim3(grid), dim3(NTHREADS), LDS_BYTES, stream, a); }
#endif
}
```
